# Optimizing an MI355X kernel written in HIP

```python
import math
import jax, jax.numpy as jnp
from jax import lax
import numpy as np

D_MODEL = 1024
BATCH = 8
SEQ = 4096
DEPTH = 1

D_RNN = 1280
RNN_BLOCK = 64
N_RNN_BLOCKS = D_RNN // RNN_BLOCK
CONV_WIDTH = 4
LRU_C = 8.0
N_HEADS_MLA = 16
QK_NOPE = 64
QK_ROPE = 32
V_HEAD = 64
Q_LORA = 384
KV_LORA = 256
ROPE_THETA = 10000.0
Q_BLOCK = 128
D_FF = 2816
FFN_CONV = 3
EPS = 1e-6
D_IN = D_RNN + Q_LORA + KV_LORA + QK_ROPE + 2 * D_MODEL

kernel_name = "hybrid_rglru_mla_convffn_adaln"


def rmsnorm(x, g):
    xf = x.astype(jnp.float32)
    y = xf * lax.rsqrt(jnp.mean(xf * xf, axis=-1, keepdims=True) + EPS)
    return (y * g.astype(jnp.float32)).astype(x.dtype)


def causal_dwconv(x, w, b):
    K = w.shape[0]
    S = x.shape[1]
    xp = jnp.pad(x, ((0, 0), (K - 1, 0), (0, 0)))
    y = xp[:, 0:S] * w[0]
    for k in range(1, K):
        y = y + xp[:, k:k + S] * w[k]
    return y + b


def rotary(x, positions):
    half = QK_ROPE // 2
    inv_freq = ROPE_THETA ** (-jnp.arange(half, dtype=jnp.float32) / half)
    ang = positions.astype(jnp.float32)[..., None] * inv_freq
    ang = ang.reshape(ang.shape[:2] + (1,) * (x.ndim - 3) + (half,))
    cos, sin = jnp.cos(ang), jnp.sin(ang)
    xf = x.astype(jnp.float32)
    x1, x2 = xf[..., :half], xf[..., half:]
    out = jnp.concatenate([x1 * cos - x2 * sin, x2 * cos + x1 * sin], axis=-1)
    return out.astype(x.dtype)


def rg_lru(xc, positions, w_a, b_a, w_x, b_x, lru_param):
    B, S, W = xc.shape
    xb = xc.reshape(B, S, N_RNN_BLOCKS, RNN_BLOCK)
    r = jax.nn.sigmoid(jnp.einsum('bsnd,nde->bsne', xb, w_a).reshape(B, S, W) + b_a)
    i = jax.nn.sigmoid(jnp.einsum('bsnd,nde->bsne', xb, w_x).reshape(B, S, W) + b_x)
    log_a = -LRU_C * r.astype(jnp.float32) * jax.nn.softplus(-lru_param.astype(jnp.float32))
    a = jnp.exp(log_a)
    mult = jnp.sqrt(-jnp.expm1(2.0 * log_a))
    reset = (positions == 0)[..., None]
    a = jnp.where(reset, 0.0, a)
    mult = jnp.where(reset, 1.0, mult)
    bterm = mult * (i * xc).astype(jnp.float32)

    def combine(lhs, rhs):
        a1, b1 = lhs
        a2, b2 = rhs
        return a1 * a2, a2 * b1 + b2

    _, h = lax.associative_scan(combine, (a, bterm), axis=1)
    return h.astype(xc.dtype)


def causal_block_attention(q, k, v):
    B, S, H, Dk = q.shape
    Dv = v.shape[-1]
    nb = S // Q_BLOCK
    scale = 1.0 / math.sqrt(Dk)
    qb = q.reshape(B, nb, Q_BLOCK, H, Dk).transpose(1, 0, 2, 3, 4)
    kpos = jnp.arange(S)

    def one_block(args):
        qi, blk = args
        s = jnp.einsum('bqhd,bkhd->bhqk', qi, k).astype(jnp.float32) * scale
        qpos = blk * Q_BLOCK + jnp.arange(Q_BLOCK)
        mask = kpos[None, :] <= qpos[:, None]
        s = jnp.where(mask[None, None], s, -jnp.inf)
        p = jax.nn.softmax(s, axis=-1).astype(v.dtype)
        return jnp.einsum('bhqk,bkhd->bqhd', p, v)

    o = lax.map(one_block, (qb, jnp.arange(nb)))
    return o.transpose(1, 0, 2, 3, 4).reshape(B, S, H * Dv)


def setup_inputs(seed: int = 0) -> dict:
    key = jax.random.key(seed)
    ks = jax.random.split(key, 32)

    def nrm(k, shape, fan_in, mult=1.0):
        return jax.random.normal(k, shape, jnp.float32) * (mult * fan_in ** -0.5)

    def gain(k, shape):
        return 1.0 + 0.02 * jax.random.normal(k, shape, jnp.float32)

    def bias(k, shape):
        return 0.01 * jax.random.normal(k, shape, jnp.float32)

    L = DEPTH
    a0 = jax.random.uniform(ks[10], (L, D_RNN), jnp.float32, 0.9, 0.999)
    s0 = a0 ** (1.0 / LRU_C)
    lru_param = jnp.log(s0) - jnp.log1p(-s0)
    positions = (jnp.arange(SEQ, dtype=jnp.int32)[None, :]
                 + jax.random.randint(ks[31], (BATCH, 1), 0, SEQ, dtype=jnp.int32))
    return {
        "x": jax.random.normal(ks[0], (BATCH, SEQ, D_MODEL), jnp.float32),
        "c": jax.random.normal(ks[1], (BATCH, D_MODEL), jnp.float32),
        "positions": positions,
        "w_ada": nrm(ks[2], (L, D_MODEL, 6 * D_MODEL), D_MODEL, 0.5),
        "b_ada": bias(ks[3], (L, 6 * D_MODEL)),
        "norm1_g": gain(ks[4], (L, D_MODEL)),
        "w_in": nrm(ks[5], (L, D_MODEL, D_IN), D_MODEL),
        "conv_w": nrm(ks[6], (L, CONV_WIDTH, D_RNN), CONV_WIDTH),
        "conv_b": bias(ks[7], (L, D_RNN)),
        "w_gate_a": nrm(ks[8], (L, N_RNN_BLOCKS, RNN_BLOCK, RNN_BLOCK), RNN_BLOCK),
        "b_gate_a": bias(ks[9], (L, D_RNN)),
        "w_gate_x": nrm(ks[11], (L, N_RNN_BLOCKS, RNN_BLOCK, RNN_BLOCK), RNN_BLOCK),
        "b_gate_x": bias(ks[12], (L, D_RNN)),
        "lru_param": lru_param,
        "q_norm_g": gain(ks[13], (L, Q_LORA)),
        "w_uq": nrm(ks[14], (L, Q_LORA, N_HEADS_MLA * (QK_NOPE + QK_ROPE)), Q_LORA),
        "kv_norm_g": gain(ks[15], (L, KV_LORA)),
        "w_ukv": nrm(ks[16], (L, KV_LORA, N_HEADS_MLA * (QK_NOPE + V_HEAD)), KV_LORA),
        "w_proj_rnn": nrm(ks[17], (L, D_RNN, D_MODEL), D_RNN),
        "w_proj_mla": nrm(ks[18], (L, N_HEADS_MLA * V_HEAD, D_MODEL), N_HEADS_MLA * V_HEAD),
        "w_out": nrm(ks[19], (L, D_MODEL, D_MODEL), D_MODEL),
        "norm2_g": gain(ks[20], (L, D_MODEL)),
        "w_up": nrm(ks[21], (L, D_MODEL, 2 * D_FF), D_MODEL),
        "ffn_conv_w": nrm(ks[22], (L, FFN_CONV, 2 * D_FF), FFN_CONV),
        "ffn_conv_b": bias(ks[23], (L, 2 * D_FF)),
        "w_down": nrm(ks[24], (L, D_FF, D_MODEL), D_FF),
        "final_g": gain(ks[25], (D_MODEL,)),
    }


def reference(x, c, positions, w_ada, b_ada, norm1_g, w_in, conv_w, conv_b,
              w_gate_a, b_gate_a, w_gate_x, b_gate_x, lru_param, q_norm_g, w_uq,
              kv_norm_g, w_ukv, w_proj_rnn, w_proj_mla, w_out, norm2_g, w_up,
              ffn_conv_w, ffn_conv_b, w_down, final_g):
    B, S, D = x.shape
    H = N_HEADS_MLA
    c_act = jax.nn.silu(c)
    for l in range(DEPTH):
        mod = c_act @ w_ada[l] + b_ada[l]
        shift1, scale1, gate1, shift2, scale2, gate2 = [m[:, None, :] for m in jnp.split(mod, 6, axis=-1)]

        h = rmsnorm(x, norm1_g[l]) * (1.0 + scale1) + shift1
        proj = h @ w_in[l]
        o0 = D_RNN
        o1 = o0 + Q_LORA
        o2 = o1 + KV_LORA
        o3 = o2 + QK_ROPE
        o4 = o3 + D_MODEL
        x_rnn, q_lat, kv_lat, k_rope, g_rnn, g_mla = (
            proj[..., :o0], proj[..., o0:o1], proj[..., o1:o2],
            proj[..., o2:o3], proj[..., o3:o4], proj[..., o4:])

        xc = causal_dwconv(x_rnn, conv_w[l], conv_b[l])
        y_rnn = rg_lru(xc, positions, w_gate_a[l], b_gate_a[l], w_gate_x[l], b_gate_x[l], lru_param[l])

        q = (rmsnorm(q_lat, q_norm_g[l]) @ w_uq[l]).reshape(B, S, H, QK_NOPE + QK_ROPE)
        q_rope = rotary(q[..., QK_NOPE:], positions)
        q = jnp.concatenate([q[..., :QK_NOPE], q_rope], axis=-1)
        kv = (rmsnorm(kv_lat, kv_norm_g[l]) @ w_ukv[l]).reshape(B, S, H, QK_NOPE + V_HEAD)
        k_nope, v = kv[..., :QK_NOPE], kv[..., QK_NOPE:]
        k_r = jnp.broadcast_to(rotary(k_rope, positions)[:, :, None, :], (B, S, H, QK_ROPE))
        k = jnp.concatenate([k_nope, k_r], axis=-1)
        y_mla = causal_block_attention(q, k, v)

        merged = (jax.nn.sigmoid(g_rnn) * (y_rnn @ w_proj_rnn[l])
                  + jax.nn.sigmoid(g_mla) * (y_mla @ w_proj_mla[l]))
        x = x + gate1 * (merged @ w_out[l])

        h2 = rmsnorm(x, norm2_g[l]) * (1.0 + scale2) + shift2
        u = causal_dwconv(h2 @ w_up[l], ffn_conv_w[l], ffn_conv_b[l])
        u_gate, u_val = u[..., :D_FF], u[..., D_FF:]
        x = x + gate2 * ((jax.nn.silu(u_gate) * u_val) @ w_down[l])

    return rmsnorm(x, final_g)
```

```cpp
#include <hip/hip_runtime.h>
#include <cstdio>
#include <cstdint>
#include <cmath>
namespace nv {
constexpr int S = 4096, DM = 1024, DRNN = 1280, QL = 384, KVL = 256, ROPE = 32, DIN = 4000, NH = 16, DFF = 2816;
__device__ __forceinline__ float sigm(float v) { return 1.f / (1.f + expf(-v)); }
__device__ __forceinline__ float siluf(float v) { return v / (1.f + expf(-v)); }

__global__ void k_mod(const float* c, const float* w, const float* bias, float* mod) {
    const int n = blockIdx.x * 256 + threadIdx.x, b = blockIdx.y;
    float acc = bias[n];
    for (int k = 0; k < DM; ++k) acc += siluf(c[b * DM + k]) * w[(size_t)k * 6144 + n];
    mod[b * 6144 + n] = acc;
}
__global__ void k_rms(const float* in, int ldi, float* out, int ldo, int ncols, const float* g, const float* sc, const float* sh, float eps) {
    __shared__ float red[256];
    const int row = blockIdx.x; const float* p = in + (size_t)row * ldi; float s = 0.f;
    for (int i = threadIdx.x; i < ncols; i += 256) s += p[i] * p[i];
    red[threadIdx.x] = s; __syncthreads();
    for (int o = 128; o > 0; o >>= 1) { if (threadIdx.x < o) red[threadIdx.x] += red[threadIdx.x + o]; __syncthreads(); }
    const float rinv = 1.f / sqrtf(red[0] / ncols + eps);
    for (int i = threadIdx.x; i < ncols; i += 256) { float v = p[i] * rinv * g[i]; if (sc) v = v * (1.f + sc[i]) + sh[i]; out[(size_t)row * ldo + i] = v; }
}
__global__ void k_gemm(const float* A, int lda, const float* B, int ldb, float* C, int ldc, int M, int N, int K) {
    __shared__ float As[16][65], Bs[16][65];
    const int tx = threadIdx.x & 15, ty = threadIdx.x >> 4, m0 = blockIdx.y * 64, n0 = blockIdx.x * 64;
    float acc[4][4] = {};
    for (int k0 = 0; k0 < K; k0 += 16) {
        for (int i = threadIdx.x; i < 1024; i += 256) { const int r = i >> 4, kk = i & 15; As[kk][r] = (m0 + r < M) ? A[(size_t)(m0 + r) * lda + k0 + kk] : 0.f; }
        for (int i = threadIdx.x; i < 1024; i += 256) { const int kk = i >> 6, cc = i & 63; Bs[kk][cc] = (n0 + cc < N) ? B[(size_t)(k0 + kk) * ldb + n0 + cc] : 0.f; }
        __syncthreads();
#pragma unroll
        for (int kk = 0; kk < 16; ++kk) { float a[4], b[4];
#pragma unroll
            for (int i = 0; i < 4; ++i) { a[i] = As[kk][ty * 4 + i]; b[i] = Bs[kk][tx * 4 + i]; }
#pragma unroll
            for (int i = 0; i < 4; ++i)
#pragma unroll
                for (int j = 0; j < 4; ++j) acc[i][j] += a[i] * b[j]; }
        __syncthreads();
    }
    for (int i = 0; i < 4; ++i) for (int j = 0; j < 4; ++j) { const int m = m0 + ty * 4 + i, n = n0 + tx * 4 + j; if (m < M && n < N) C[(size_t)m * ldc + n] = acc[i][j]; }
}
__global__ void k_conv(const float* in, int ldi, int col0, float* out, int ldo, int C, int KW, const float* w, const float* b) {
    const int idx = blockIdx.x * 256 + threadIdx.x; if (idx >= S * C) return; const int t = idx / C, c = idx % C;
    float acc = b[c];
    for (int k = 0; k < KW; ++k) { const int tt = t - (KW - 1) + k; if (tt >= 0) acc += w[k * C + c] * in[(size_t)tt * ldi + col0 + c]; }
    out[(size_t)t * ldo + c] = acc;
}
__global__ void k_gates(const float* xc, const int* pos, const float* wa, const float* ba, const float* wx, const float* bx, const float* lru, float* a_out, float* b_out) {
    const int idx = blockIdx.x * 256 + threadIdx.x; if (idx >= S * DRNN) return; const int t = idx / DRNN, c = idx % DRNN, n = c / 64, e = c % 64;
    float za = ba[c], zx = bx[c];
    for (int d = 0; d < 64; ++d) { const float xv = xc[(size_t)t * DRNN + n * 64 + d]; za += xv * wa[(n * 64 + d) * 64 + e]; zx += xv * wx[(n * 64 + d) * 64 + e]; }
    const float r = sigm(za), i = sigm(zx); const float L = lru[c]; const float sp = (-L > 20.f) ? -L : log1pf(expf(-L));
    const float log_a = -8.f * r * sp; float a = expf(log_a), mult = sqrtf(-expm1f(2.f * log_a));
    if (pos[t] == 0) { a = 0.f; mult = 1.f; }
    a_out[idx] = a; b_out[idx] = mult * (i * xc[idx]);
}
__global__ void k_scan(const float* a, const float* b, float* y) {
    const int c = blockIdx.x * 256 + threadIdx.x; if (c >= DRNN) return; float h = 0.f;
    for (int t = 0; t < S; ++t) { h = a[(size_t)t * DRNN + c] * h + b[(size_t)t * DRNN + c]; y[(size_t)t * DRNN + c] = h; }
}
__global__ void k_rope(float* buf, int ld, int col0, int hstride, int nheads, const int* pos) {
    const int idx = blockIdx.x * 256 + threadIdx.x; if (idx >= S * nheads * 16) return; const int j = idx % 16, h = (idx / 16) % nheads, t = idx / (16 * nheads);
    const float inv = powf(10000.f, -(float)j / 16.f); const float ang = (float)pos[t] * inv; const float cs = cosf(ang), sn = sinf(ang);
    float* p = buf + (size_t)t * ld + col0 + h * hstride; const float x1 = p[j], x2 = p[j + 16];
    p[j] = x1 * cs - x2 * sn; p[j + 16] = x2 * cs + x1 * sn;
}
__global__ void __launch_bounds__(64) k_attn(const float* q, const float* kv, const float* kr, int ldkr, int colkr, float* y) {
    const int h = blockIdx.y, tq = blockIdx.x * 64 + threadIdx.x; float qv[96], o[64];
    for (int d = 0; d < 96; ++d) qv[d] = q[(size_t)tq * 1536 + h * 96 + d] * 0.10206207261596575f;
    for (int d = 0; d < 64; ++d) o[d] = 0.f;
    float m = -1e30f, l = 0.f; const int kmax = blockIdx.x * 64 + 63;
    for (int tk = 0; tk <= kmax; ++tk) {
        const float* kp = kv + (size_t)tk * 2048 + h * 128; const float* rp = kr + (size_t)tk * ldkr + colkr; float s = 0.f;
#pragma unroll
        for (int d = 0; d < 64; ++d) s += qv[d] * kp[d];
#pragma unroll
        for (int d = 0; d < 32; ++d) s += qv[64 + d] * rp[d];
        if (tk > tq) s = -INFINITY;
        const float mn = fmaxf(m, s), al = expf(m - mn), p = expf(s - mn); l = l * al + p;
#pragma unroll
        for (int d = 0; d < 64; ++d) o[d] = o[d] * al + p * kp[64 + d];
        m = mn;
    }
    for (int d = 0; d < 64; ++d) y[(size_t)tq * 1024 + h * 64 + d] = o[d] / l;
}
__global__ void k_merge(const float* proj, const float* pr, const float* pm, float* mg) {
    const int idx = blockIdx.x * 256 + threadIdx.x; if (idx >= S * DM) return; const int t = idx / DM, n = idx % DM;
    mg[idx] = sigm(proj[(size_t)t * DIN + 1952 + n]) * pr[idx] + sigm(proj[(size_t)t * DIN + 2976 + n]) * pm[idx];
}
__global__ void k_resid(const float* xin, const float* d, const float* gate, float* xout) {
    const int idx = blockIdx.x * 256 + threadIdx.x; if (idx >= S * DM) return; xout[idx] = xin[idx] + gate[idx % DM] * d[idx];
}
__global__ void k_glu(const float* u, float* act) {
    const int idx = blockIdx.x * 256 + threadIdx.x; if (idx >= S * DFF) return; const int t = idx / DFF, f = idx % DFF;
    act[idx] = siluf(u[(size_t)t * 5632 + f]) * u[(size_t)t * 5632 + DFF + f];
}
inline void gemm(hipStream_t st, const float* A, int lda, const float* B, int ldb, float* C, int ldc, int M, int N, int K) {
    k_gemm<<<dim3((N + 63) / 64, (M + 63) / 64), 256, 0, st>>>(A, lda, B, ldb, C, ldc, M, N, K);
}
inline void forward(void* const* d_in, float* out, float* ws, hipStream_t st, int b_lo = 0, int b_hi = 8) {
    const float* x = (const float*)d_in[0]; const float* c = (const float*)d_in[1]; const int* pos = (const int*)d_in[2];
#define IN(i) ((const float*)d_in[i])
    float* p = ws;
    auto take = [&](size_t n) { float* r = p; p += (n + 63) / 64 * 64; return r; };
    float* mod = take(8 * 6144);
    float* h = take((size_t)S * DM); float* proj = take((size_t)S * DIN); float* xc = take((size_t)S * DRNN); float* ga = take((size_t)S * DRNN); float* gb = take((size_t)S * DRNN);
    float* yr = take((size_t)S * DRNN); float* qn = take((size_t)S * QL); float* kvn = take((size_t)S * KVL); float* q = take((size_t)S * 1536); float* kv = take((size_t)S * 2048);
    float* ym = take((size_t)S * DM); float* pr = take((size_t)S * DM); float* pm = take((size_t)S * DM); float* mg = take((size_t)S * DM); float* x1 = take((size_t)S * DM);
    float* u = proj; float* uc = gb; float* act = take((size_t)S * DFF);
    k_mod<<<dim3(24, 8), 256, 0, st>>>(c, IN(3), IN(4), mod);
    for (int b = b_lo; b < b_hi; ++b) {
        const float* xb = x + (size_t)b * S * DM; const int* pb = pos + b * S; const float* md = mod + b * 6144; float* ob = out + (size_t)b * S * DM;
        k_rms<<<S, 256, 0, st>>>(xb, DM, h, DM, DM, IN(5), md + 1024, md, 1e-6f);
        gemm(st, h, DM, IN(6), DIN, proj, DIN, S, DIN, DM);
        k_conv<<<(S * DRNN + 255) / 256, 256, 0, st>>>(proj, DIN, 0, xc, DRNN, DRNN, 4, IN(7), IN(8));
        k_gates<<<(S * DRNN + 255) / 256, 256, 0, st>>>(xc, pb, IN(9), IN(10), IN(11), IN(12), IN(13), ga, gb);
        k_scan<<<5, 256, 0, st>>>(ga, gb, yr);
        k_rms<<<S, 256, 0, st>>>(proj + 1280, DIN, qn, QL, QL, IN(14), nullptr, nullptr, 1e-6f);
        k_rms<<<S, 256, 0, st>>>(proj + 1664, DIN, kvn, KVL, KVL, IN(16), nullptr, nullptr, 1e-6f);
        gemm(st, qn, QL, IN(15), 1536, q, 1536, S, 1536, QL);
        gemm(st, kvn, KVL, IN(17), 2048, kv, 2048, S, 2048, KVL);
        k_rope<<<(S * 16 * 16 + 255) / 256, 256, 0, st>>>(q, 1536, 64, 96, 16, pb);
        k_rope<<<(S * 16 + 255) / 256, 256, 0, st>>>(proj, DIN, 1920, 0, 1, pb);
        k_attn<<<dim3(S / 64, NH), 64, 0, st>>>(q, kv, proj, DIN, 1920, ym);
        gemm(st, yr, DRNN, IN(18), DM, pr, DM, S, DM, DRNN);
        gemm(st, ym, DM, IN(19), DM, pm, DM, S, DM, DM);
        k_merge<<<(S * DM) / 256, 256, 0, st>>>(proj, pr, pm, mg);
        gemm(st, mg, DM, IN(20), DM, pr, DM, S, DM, DM);
        k_resid<<<(S * DM) / 256, 256, 0, st>>>(xb, pr, md + 2048, x1);
        k_rms<<<S, 256, 0, st>>>(x1, DM, h, DM, DM, IN(21), md + 4096, md + 3072, 1e-6f);
        gemm(st, h, DM, IN(22), 5632, u, 5632, S, 5632, DM);
        k_conv<<<(S * 5632 + 255) / 256, 256, 0, st>>>(u, 5632, 0, uc, 5632, 5632, 3, IN(23), IN(24));
        k_glu<<<(S * DFF + 255) / 256, 256, 0, st>>>(uc, act);
        gemm(st, act, DFF, IN(25), DM, pm, DM, S, DM, DFF);
        k_resid<<<(S * DM) / 256, 256, 0, st>>>(x1, pm, md + 5120, x1);
        k_rms<<<S, 256, 0, st>>>(x1, DM, ob, DM, DM, IN(26), nullptr, nullptr, 1e-6f);
    }
#undef IN
}
}

extern "C" void kernel_launch(void* const* d_in, const int* in_sizes, int n_in, void* d_out, int out_size, void* d_ws, size_t ws_size, hipStream_t stream) {
    nv::forward(d_in, (float*)d_out, (float*)d_ws, stream);
}
```

```cpp
#include <hip/hip_runtime.h>
#include <cstdio>
#include <cstdint>
#include <cmath>
namespace pg8 {
#define PG8_LAS __attribute__((address_space(3)))
typedef unsigned short bf16_t;
typedef short bf16x8 __attribute__((ext_vector_type(8)));
typedef float f32x4 __attribute__((ext_vector_type(4)));
typedef float f32x2 __attribute__((ext_vector_type(2)));
typedef unsigned u32x4 __attribute__((ext_vector_type(4)));
typedef unsigned u32x2 __attribute__((ext_vector_type(2)));
constexpr int BM = 256, BK = 64, HALF = 128, HTB = HALF * BK * 2  , STAGE_BYTES = 8 * HTB, NXCD = 8, WGM = 8;

__host__ __device__ __forceinline__ int lds_byte(int r, int c) { const int st = (r >> 4) * 2 + (c >> 5), rr = r & 15, cc = c & 31, ob = rr * 64 + cc * 2; return st * 1024 + (ob ^ (((ob >> 9) & 1) << 5)); }
__host__ __device__ __forceinline__ void stage_rc(int b, int& R, int& C) { const int st = b / 1024, sb = b % 1024, swz = sb ^ (((sb >> 9) & 1) << 5); R = (st >> 1) * 16 + swz / 64; C = (st & 1) * 32 + (swz % 64) / 2; }
__host__ __device__ __forceinline__ int perm32(int rho) { const int n = rho >> 4, i = rho & 15; return 8 * (i >> 2) + 4 * n + (i & 3); }

struct Unit { int pm, pn; };
struct Gemm { const bf16_t* A; const bf16_t* Bt; int lda, ldb, K; };

struct StaticOrder {
    int nM, nN, nwg, G, c;
    __host__ __device__ void init(int M, int N, int G_, int c_) { nM = M / BM; nN = N / BM; nwg = nM * nN; G = G_; c = c_; }
    __host__ __device__ bool next(int i, Unit& u) const {
        const long L = (long)i * G + c; if (L >= nwg) return false;
        int wgid = (int)L; { const int q = nwg / NXCD, r = nwg % NXCD, xcd = wgid % NXCD, off = wgid / NXCD; wgid = (xcd < r ? xcd * (q + 1) : r * (q + 1) + (xcd - r) * q) + off; }
        const int nig = WGM * nN, gid = wgid / nig, fm = gid * WGM, gsz = (nM - fm) < WGM ? (nM - fm) : WGM;
        u.pm = fm + ((wgid % nig) % gsz); u.pn = (wgid % nig) / gsz; return true;
    }
};
typedef __bf16 bf16x2_t __attribute__((ext_vector_type(2)));
__device__ __forceinline__ unsigned cvt_pk_bf16(float lo, float hi) { f32x2 v = {lo, hi}; bf16x2_t b = __builtin_convertvector(v, bf16x2_t); return __builtin_bit_cast(unsigned, b); }

template <class Epi, class Sched, bool ALIGN_EPI = false, bool SP2 = false>
__device__ __forceinline__ void gemm_phase(PG8_LAS unsigned char* lds, const Gemm g, const Sched& S, const Epi& E, const int wid_) {
    int z_; asm volatile("v_mov_b32 %0, 0" : "=v"(z_));
    const int wid = wid_, lane = __builtin_amdgcn_mbcnt_hi(~0u, __builtin_amdgcn_mbcnt_lo(~0u, z_)), tid = wid * 64 + lane, wr = wid >> 2, wc = wid & 3, fr = lane & 15, fq = lane >> 4;
    const int K = g.K, nt = K / BK;
    unsigned voffA[2], voffB[2];
#pragma unroll
    for (int i = 0; i < 2; ++i) { int R, C; stage_rc(tid * 16 + i * 8192, R, C); const int Rb = Epi::PERM ? ((R & ~31) + perm32(R & 31)) : R;
        voffA[i] = (unsigned)(R * g.lda + C) * 2u; voffB[i] = (unsigned)(Rb * g.ldb + C) * 2u; }
    const size_t kstep = (size_t)(BK * 2);
    const size_t hA = (size_t)HALF * g.lda * 2, hB = (size_t)HALF * g.ldb * 2;
    const size_t tA = 2 * hA, tB = 2 * hB;
    const unsigned ldsw = (unsigned)wid * 1024u;
    const int aoff = lds_byte(wr * 64 + fr, fq * 8), boff = lds_byte(wc * 32 + fr, fq * 8);
#define PG8_SA(b, h) (((b) * 2 + (h)) * HTB)
#define PG8_SB(b, h) ((4 + (b) * 2 + (h)) * HTB)
#define PG8_STAGE(bufoff, gbase, voff) do { _Pragma("unroll") for (int _i = 0; _i < 2; ++_i) \
        __builtin_amdgcn_global_load_lds((const unsigned*)((const char*)(gbase) + (voff)[_i]), (PG8_LAS unsigned*)(lds + (bufoff) + ldsw + _i * 8192), 16, 0, 0); } while (0)
#define PG8_LDA(dst, b, h) do { _Pragma("unroll") for (int m = 0; m < 4; ++m) _Pragma("unroll") for (int k = 0; k < 2; ++k) dst[m][k] = *(const PG8_LAS bf16x8*)(lds + PG8_SA(b, h) + aoff + m * 2048 + k * 1024); } while (0)
#define PG8_LDB(dst, b, h) do { _Pragma("unroll") for (int n = 0; n < 2; ++n) _Pragma("unroll") for (int k = 0; k < 2; ++k) dst[n][k] = *(const PG8_LAS bf16x8*)(lds + PG8_SB(b, h) + boff + n * 2048 + k * 1024); } while (0)
#define PG8_MMA(ai, bj, At, Bt) do { __builtin_amdgcn_s_setprio(1); _Pragma("unroll") for (int m = 0; m < 4; ++m) _Pragma("unroll") for (int n = 0; n < 2; ++n) _Pragma("unroll") for (int k = 0; k < 2; ++k) \
        acc[ai][bj][m][n] = __builtin_amdgcn_mfma_f32_16x16x32_bf16(Bt[n][k], At[m][k], acc[ai][bj][m][n], 0, 0, 0); __builtin_amdgcn_s_setprio(0); } while (0)
#define PG8_WAIT_V(n) asm volatile("s_waitcnt vmcnt(" #n ")" ::: "memory")
#define PG8_WAIT_L(n) asm volatile("s_waitcnt lgkmcnt(" #n ")" ::: "memory")
#define PG8_BAR __builtin_amdgcn_s_barrier()
#define PG8_SCHED __builtin_amdgcn_sched_barrier(0)
    Unit cur, nxt; int ui = 0;
    if (!S.next(0, cur)) return;
    f32x4 acc[2][2][4][2];
#pragma unroll
    for (int a = 0; a < 2; ++a)
#pragma unroll
        for (int b = 0; b < 2; ++b)
#pragma unroll
            for (int m = 0; m < 4; ++m)
#pragma unroll
                for (int n = 0; n < 2; ++n) acc[a][b][m][n] = (f32x4){0.f, 0.f, 0.f, 0.f};
    bf16x8 At[4][2], B0[2][2], B1[2][2];
    const char* cA = (const char*)g.A + (size_t)cur.pm * tA; const char* cB = (const char*)g.Bt + (size_t)cur.pn * tB;
    if constexpr (SP2) {
        PG8_STAGE(PG8_SB(0, 0), cB, voffB); PG8_STAGE(PG8_SB(0, 1), cB + hB, voffB); PG8_STAGE(PG8_SA(0, 0), cA, voffA); PG8_STAGE(PG8_SA(0, 1), cA + hA, voffA);
        if (wr == 1) PG8_BAR;
        PG8_WAIT_V(2); PG8_BAR;
        PG8_STAGE(PG8_SB(1, 0), cB + kstep, voffB); PG8_STAGE(PG8_SA(1, 0), cA + kstep, voffA); PG8_STAGE(PG8_SB(1, 1), cB + hB + kstep, voffB);
        PG8_WAIT_V(6); PG8_BAR;
    } else {
        PG8_STAGE(PG8_SB(0, 0), cB, voffB); PG8_STAGE(PG8_SA(0, 0), cA, voffA); PG8_STAGE(PG8_SB(0, 1), cB + hB, voffB); PG8_STAGE(PG8_SA(0, 1), cA + hA, voffA);
        if (wr == 1) PG8_BAR;
        PG8_WAIT_V(4); PG8_BAR;
        PG8_STAGE(PG8_SB(1, 0), cB + kstep, voffB); PG8_STAGE(PG8_SA(1, 0), cA + kstep, voffA); PG8_STAGE(PG8_SB(1, 1), cB + hB + kstep, voffB);
        PG8_WAIT_V(6); PG8_BAR;
    }
    for (;;) {
        const bool has_next = S.next(ui + 1, nxt);
        const char* nA = has_next ? (const char*)g.A + (size_t)nxt.pm * tA : cA; const char* nB = has_next ? (const char*)g.Bt + (size_t)nxt.pn * tB : cB;
        for (int t = 0; t < nt; t += 2) {
            const bool last = (t == nt - 2);
            const char* a1 = cA + (size_t)(t + 1) * kstep;
            const char* a2 = last ? nA : cA + (size_t)(t + 2) * kstep; const char* b2 = last ? nB : cB + (size_t)(t + 2) * kstep;
            const char* a3 = a2 + kstep; const char* b3 = b2 + kstep;
            if constexpr (SP2) {
            PG8_LDB(B0, 0, 0); PG8_LDB(B1, 0, 1); PG8_SCHED; PG8_LDA(At, 0, 0); PG8_STAGE(PG8_SA(1, 1), a1 + hA, voffA);
            PG8_WAIT_V(8); PG8_WAIT_L(0); PG8_BAR; PG8_MMA(0, 0, At, B0); PG8_MMA(0, 1, At, B1); PG8_BAR; PG8_SCHED;
            PG8_LDA(At, 0, 1); PG8_STAGE(PG8_SB(0, 0), b2, voffB); PG8_STAGE(PG8_SB(0, 1), b2 + hB, voffB); PG8_STAGE(PG8_SA(0, 0), a2, voffA);
            PG8_WAIT_V(8); PG8_WAIT_L(0); PG8_BAR; PG8_MMA(1, 0, At, B0); PG8_MMA(1, 1, At, B1); PG8_BAR; PG8_SCHED;
            PG8_LDB(B0, 1, 0); PG8_LDB(B1, 1, 1); PG8_SCHED; PG8_LDA(At, 1, 0); PG8_STAGE(PG8_SA(0, 1), a2 + hA, voffA);
            PG8_WAIT_V(8); PG8_WAIT_L(0); PG8_BAR; PG8_MMA(0, 0, At, B0); PG8_MMA(0, 1, At, B1); PG8_BAR; PG8_SCHED;
            PG8_LDA(At, 1, 1); PG8_STAGE(PG8_SB(1, 0), b3, voffB); PG8_STAGE(PG8_SB(1, 1), b3 + hB, voffB); PG8_STAGE(PG8_SA(1, 0), a3, voffA);
            PG8_WAIT_V(8); PG8_WAIT_L(0); PG8_BAR; PG8_MMA(1, 0, At, B0); PG8_MMA(1, 1, At, B1); PG8_BAR; PG8_SCHED;
            } else {
            PG8_LDB(B0, 0, 0); PG8_SCHED; PG8_LDA(At, 0, 0); PG8_STAGE(PG8_SA(1, 1), a1 + hA, voffA);
            PG8_WAIT_L(8); PG8_BAR; PG8_WAIT_L(0); PG8_MMA(0, 0, At, B0); PG8_BAR; PG8_SCHED;
            PG8_LDB(B1, 0, 1); PG8_STAGE(PG8_SB(0, 0), b2, voffB);
            PG8_BAR; PG8_WAIT_L(0); PG8_MMA(0, 1, At, B1); PG8_BAR;
            PG8_LDA(At, 0, 1); PG8_STAGE(PG8_SA(0, 0), a2, voffA);
            PG8_BAR; PG8_WAIT_L(0); PG8_MMA(1, 0, At, B0); PG8_BAR; PG8_SCHED;
            PG8_STAGE(PG8_SB(0, 1), b2 + hB, voffB);
            PG8_WAIT_V(6); PG8_BAR; PG8_MMA(1, 1, At, B1); PG8_BAR;
            PG8_LDB(B0, 1, 0); PG8_SCHED; PG8_LDA(At, 1, 0); PG8_STAGE(PG8_SA(0, 1), a2 + hA, voffA);
            PG8_WAIT_L(8); PG8_BAR; PG8_WAIT_L(0); PG8_MMA(0, 0, At, B0); PG8_BAR; PG8_SCHED;
            PG8_LDB(B1, 1, 1); PG8_STAGE(PG8_SB(1, 0), b3, voffB);
            PG8_BAR; PG8_WAIT_L(0); PG8_MMA(0, 1, At, B1); PG8_BAR;
            PG8_LDA(At, 1, 1); PG8_STAGE(PG8_SA(1, 0), a3, voffA);
            PG8_BAR; PG8_WAIT_L(0); PG8_MMA(1, 0, At, B0); PG8_BAR; PG8_SCHED;
            PG8_STAGE(PG8_SB(1, 1), b3 + hB, voffB);
            PG8_WAIT_V(6); PG8_BAR; PG8_MMA(1, 1, At, B1); PG8_BAR;
            }
        }
        if constexpr (ALIGN_EPI) { if (wr == 0) PG8_BAR; }
        E(acc, cur, wr, wc);
        if (!has_next) break;
#pragma unroll
        for (int a = 0; a < 2; ++a)
#pragma unroll
            for (int b = 0; b < 2; ++b)
#pragma unroll
                for (int m = 0; m < 4; ++m)
#pragma unroll
                    for (int n = 0; n < 2; ++n) acc[a][b][m][n] = (f32x4){0.f, 0.f, 0.f, 0.f};
        cur = nxt; cA = nA; cB = nB; ++ui;
        if constexpr (ALIGN_EPI) { if (wr == 1) PG8_BAR; }
    }
    PG8_WAIT_V(0);
    if constexpr (!ALIGN_EPI) { if (wr == 0) PG8_BAR; }
    PG8_BAR;
#undef PG8_SA
#undef PG8_SB
#undef PG8_STAGE
#undef PG8_LDA
#undef PG8_LDB
#undef PG8_MMA
#undef PG8_WAIT_V
#undef PG8_WAIT_L
#undef PG8_BAR
#undef PG8_SCHED
}
}
#define LAS __attribute__((address_space(3)))
typedef unsigned short bf16;
typedef float f32x4 __attribute__((ext_vector_type(4)));
typedef float f32x2 __attribute__((ext_vector_type(2)));
typedef float f32x16 __attribute__((ext_vector_type(16)));
typedef short bf16x8 __attribute__((ext_vector_type(8)));
typedef short s16x4 __attribute__((ext_vector_type(4)));
typedef unsigned u32x4 __attribute__((ext_vector_type(4)));
typedef unsigned u32x2 __attribute__((ext_vector_type(2)));
using pg8::Unit; using pg8::cvt_pk_bf16;
#define RLX_AGENT __ATOMIC_RELAXED, __HIP_MEMORY_SCOPE_AGENT
#define LDS_WAIT() asm volatile("s_waitcnt lgkmcnt(0)" ::: "memory")
#define VM_WAIT() asm volatile("s_waitcnt vmcnt(0)" ::: "memory")

constexpr int NB = 8, SEQ = 4096, NT = NB * SEQ, DM = 1024, DRNN = 1280, QL = 384, KVL = 256, DIN = 4000, NH = 16, DFF = 2816, NUP = 2 * DFF;
constexpr float EPS = 1e-6f;
constexpr float LOG2E = 1.4426950408889634f;
constexpr float QSCALE = 0.10206207261596575f * 1.4426950408889634f;

constexpr size_t MiB = 1u << 20;
constexpr size_t WS_CTL = 0, CTL_ZERO_BYTES = 1 * MiB;
constexpr size_t CTL_BAR = 16384;
constexpr size_t CTL_MOD = 65536;
constexpr size_t CTL_SSQQ = 262144, CTL_SSQKV = 393216;
constexpr size_t WS_WIN = 1 * MiB, WS_WUQ = 9 * MiB, WS_WUKV = 11 * MiB, WS_WPR = 12 * MiB, WS_WPM = 15 * MiB, WS_WOUT = 17 * MiB, WS_WUP = 19 * MiB, WS_WDN = 30 * MiB;
constexpr size_t WS_COS = 36 * MiB, WS_SIN = 38 * MiB;
constexpr size_t WS_R1 = 40 * MiB;
constexpr size_t WS_R2 = 120 * MiB;
constexpr size_t WS_LAT = 200 * MiB;
constexpr size_t WS_Q = 248 * MiB;
constexpr size_t WS_KN = 344 * MiB, WS_V = 408 * MiB, WS_KR = 472 * MiB, WS_END = 474 * MiB;

__device__ __forceinline__ u32x4 pack8(f32x4 a, f32x4 b) { u32x4 w; w.x = cvt_pk_bf16(a[0], a[1]); w.y = cvt_pk_bf16(a[2], a[3]); w.z = cvt_pk_bf16(b[0], b[1]); w.w = cvt_pk_bf16(b[2], b[3]); return w; }
__device__ __forceinline__ float bflo(unsigned w) { return __uint_as_float(w << 16); }
__device__ __forceinline__ float bfhi(unsigned w) { return __uint_as_float(w & 0xffff0000u); }
__device__ __forceinline__ float fsigmoid(float v) { return __builtin_amdgcn_rcpf(1.f + __builtin_amdgcn_exp2f(-LOG2E * v)); }
__device__ __forceinline__ float sumsq4(f32x4 v) { return (v[0] * v[0] + v[1] * v[1]) + (v[2] * v[2] + v[3] * v[3]); }
__device__ __forceinline__ float wave_sum(float v) {
#pragma unroll
    for (int o = 1; o < 64; o <<= 1) v += __shfl_xor(v, o);
    return v;
}

#define XB_TMO      128
#define XB_XCNT(j)  (256  + 64 * (j))
#define XB_XSUB(j)  (1280 + 64 * (j))
#define XB_XGEN(j)  (2304 + 64 * (j))
#define XB_TOP      3328
#define XB_TOPGEN   3392
#define XCD_BAR_WORDS 3456
#define XB_SPIN_CAP (1u << 18)
__device__ __forceinline__ unsigned xb_ld(unsigned* p)              { return __hip_atomic_load(p, __ATOMIC_RELAXED, __HIP_MEMORY_SCOPE_AGENT); }
__device__ __forceinline__ unsigned xb_add(unsigned* p, unsigned v) { return __hip_atomic_fetch_add(p, v, __ATOMIC_RELAXED, __HIP_MEMORY_SCOPE_AGENT); }
__device__ __forceinline__ unsigned xb_xcc_id() { return (unsigned)__builtin_amdgcn_s_getreg((3 << 11) | 20) & 0xFu; }
#define XB_SPIN(cond, bar) do { unsigned _sp = 0; while (cond) { __builtin_amdgcn_s_sleep(1); \
    if ((++_sp & 255u) == 0u) { if (xb_ld(&(bar)[XB_TMO])) break; if (_sp > XB_SPIN_CAP) { atomicAdd(&(bar)[XB_TMO], 1u); break; } } } } while (0)
struct XcdBarrier { unsigned* bar; unsigned x; volatile LAS unsigned* st; };
__device__ __forceinline__ XcdBarrier xcd_barrier_post(unsigned* bar, volatile LAS unsigned* st) {
    XcdBarrier b; b.bar = bar; b.x = xb_xcc_id(); b.st = st;
    if (threadIdx.x == 0) (void)xb_add(&bar[XB_XCNT(b.x)], 1u);
    return b;
}
__device__ __forceinline__ void xcd_barrier_complete(unsigned* bar, unsigned x, unsigned& nloc, unsigned& nx) {
    const unsigned G = gridDim.x * gridDim.y * gridDim.z;
    unsigned sum, cnt, mine, sp = 0u;
    for (;;) {
        sum = 0u; cnt = 0u; mine = 0u;
#pragma unroll
        for (unsigned j = 0; j < 16; ++j) { const unsigned c = xb_ld(&bar[XB_XCNT(j)]); sum += c; cnt += (c > 0u) ? 1u : 0u; mine = (j == x) ? c : mine; }
        if (sum == G) break;
        __builtin_amdgcn_s_sleep(1);
        if ((++sp & 255u) == 0u) { if (xb_ld(&bar[XB_TMO])) break; if (sp > XB_SPIN_CAP) { atomicAdd(&bar[XB_TMO], 1u); break; } }
    }
    nloc = mine > 0u ? mine : 1u; nx = cnt > 0u ? cnt : 1u;
}
__device__ __forceinline__ void xcd_barrier(const XcdBarrier& b) {
    asm volatile("s_waitcnt vmcnt(0)" ::: "memory");
    __syncthreads();
    if (threadIdx.x == 0) {
        unsigned* bar = b.bar;
        __builtin_amdgcn_s_waitcnt(0);
        unsigned nloc = b.st[0], nx = b.st[1];
        if (nloc == 0u) { xcd_barrier_complete(bar, b.x, nloc, nx); b.st[0] = nloc; b.st[1] = nx; }
        const unsigned old = xb_add(&bar[XB_XSUB(b.x)], 1u);
        const unsigned gen = old / nloc;
        if (old + 1u == (gen + 1u) * nloc) {
            __builtin_amdgcn_fence(__ATOMIC_RELEASE, "agent");
            asm volatile("s_waitcnt vmcnt(0)" ::: "memory");
            const unsigned og = xb_add(&bar[XB_TOP], 1u);
            const unsigned tg = og / nx;
            if (og + 1u == (tg + 1u) * nx) xb_add(&bar[XB_TOPGEN], 1u);
            else XB_SPIN(xb_ld(&bar[XB_TOPGEN]) == tg, bar);
            __builtin_amdgcn_fence(__ATOMIC_ACQUIRE, "agent");
            xb_add(&bar[XB_XGEN(b.x)], 1u);
            asm volatile("s_waitcnt vmcnt(0)" ::: "memory");
        } else {
            XB_SPIN(xb_ld(&bar[XB_XGEN(b.x)]) == gen, bar);
            __builtin_amdgcn_fence(__ATOMIC_ACQUIRE, "agent");
            asm volatile("s_waitcnt vmcnt(0)" ::: "memory");
        }
    }
    __syncthreads();
}
__device__ __forceinline__ void rope8(f32x4& v0, f32x4& v1, const float* cosT, const float* sinT, int row, int fq) {
    const float* cp = cosT + (size_t)row * 16 + 4 * fq; const float* sp = sinT + (size_t)row * 16 + 4 * fq;
    { const f32x2 c = *(const f32x2*)cp, s = *(const f32x2*)sp; const float x0 = v0[0], x1 = v0[1], x2 = v0[2], x3 = v0[3];
      v0[0] = x0 * c[0] - x1 * s[0]; v0[1] = x1 * c[0] + x0 * s[0]; v0[2] = x2 * c[1] - x3 * s[1]; v0[3] = x3 * c[1] + x2 * s[1]; }
    asm volatile("" : "+v"(v0));
    { const f32x2 c = *(const f32x2*)(cp + 2), s = *(const f32x2*)(sp + 2); const float x0 = v1[0], x1 = v1[1], x2 = v1[2], x3 = v1[3];
      v1[0] = x0 * c[0] - x1 * s[0]; v1[1] = x1 * c[0] + x0 * s[0]; v1[2] = x2 * c[1] - x3 * s[1]; v1[3] = x3 * c[1] + x2 * s[1]; }
}
struct EpiIn {
    static constexpr bool PERM = true;
    bf16 *XR, *LAT, *KR, *SG; float *ssq_q, *ssq_kv; const float *cosT, *sinT;
    __device__ __forceinline__ void operator()(f32x4 (&acc)[2][2][4][2], const Unit& u, int wr, int wc) const {
        int z_; asm volatile("v_mov_b32 %0, 0" : "=v"(z_)); const int lane_ = __builtin_amdgcn_mbcnt_hi(~0u, __builtin_amdgcn_mbcnt_lo(~0u, z_)), fr = lane_ & 15, fq = lane_ >> 4;
        const int row0 = u.pm * 256 + wr * 64 + fr, pn = u.pn, cw = wc * 32 + 8 * fq;
        if (pn < 5) {
#pragma unroll
            for (int ai = 0; ai < 2; ++ai)
#pragma unroll
                for (int m = 0; m < 4; ++m) { bf16* rowp = XR + (size_t)(row0 + ai * 128 + m * 16) * DRNN + pn * 256 + cw;
#pragma unroll
                    for (int bj = 0; bj < 2; ++bj) *(u32x4*)(rowp + bj * 128) = pack8(acc[ai][bj][m][0], acc[ai][bj][m][1]); }
        } else if (pn < 8) {
            const int ct = (pn - 5) * 256;
#pragma unroll
            for (int ai = 0; ai < 2; ++ai)
#pragma unroll
                for (int m = 0; m < 4; ++m) { const int row = row0 + ai * 128 + m * 16; bf16* rowp = LAT + (size_t)row * 768 + ct + cw;
                    float s0 = sumsq4(acc[ai][0][m][0]) + sumsq4(acc[ai][0][m][1]), s1 = sumsq4(acc[ai][1][m][0]) + sumsq4(acc[ai][1][m][1]);
                    *(u32x4*)(rowp) = pack8(acc[ai][0][m][0], acc[ai][0][m][1]);
                    if (pn != 7) *(u32x4*)(rowp + 128) = pack8(acc[ai][1][m][0], acc[ai][1][m][1]);
                    else if (wc == 0) { f32x4 v0 = acc[ai][1][m][0], v1 = acc[ai][1][m][1]; rope8(v0, v1, cosT, sinT, row, fq); *(u32x4*)(KR + (size_t)row * 32 + 8 * fq) = pack8(v0, v1); }
                    if (pn == 5) { s0 += s1; s1 = 0.f; }
                    s0 += __shfl_xor(s0, 16); s0 += __shfl_xor(s0, 32); s1 += __shfl_xor(s1, 16); s1 += __shfl_xor(s1, 32);
                    if (fq == 0) { if (pn == 7) unsafeAtomicAdd(ssq_kv + row, s0); else { unsafeAtomicAdd(ssq_q + row, s0); if (pn == 6) unsafeAtomicAdd(ssq_kv + row, s1); } } }
        } else {
            const int ct = (pn - 8) * 256;
#pragma unroll
            for (int ai = 0; ai < 2; ++ai)
#pragma unroll
                for (int m = 0; m < 4; ++m) { bf16* rowp = SG + (size_t)(row0 + ai * 128 + m * 16) * 2048 + ct + cw;
#pragma unroll
                    for (int bj = 0; bj < 2; ++bj) { f32x4 a = acc[ai][bj][m][0], b = acc[ai][bj][m][1];
#pragma unroll
                        for (int e = 0; e < 4; ++e) { a[e] = fsigmoid(a[e]); b[e] = fsigmoid(b[e]); }
                        *(u32x4*)(rowp + bj * 128) = pack8(a, b); } }
        }
    }
};
struct EpiQ {
    static constexpr bool PERM = true;
    bf16* Q; const float* ssq; const float *cosT, *sinT;
    __device__ __forceinline__ void operator()(f32x4 (&acc)[2][2][4][2], const Unit& u, int wr, int wc) const {
        int z_; asm volatile("v_mov_b32 %0, 0" : "=v"(z_)); const int lane_ = __builtin_amdgcn_mbcnt_hi(~0u, __builtin_amdgcn_mbcnt_lo(~0u, z_)), fr = lane_ & 15, fq = lane_ >> 4;
        const int row0 = u.pm * 256 + wr * 64 + fr, pn = u.pn, cw = wc * 32 + 8 * fq;
#pragma unroll
        for (int ai = 0; ai < 2; ++ai)
#pragma unroll
            for (int m = 0; m < 4; ++m) { const int row = row0 + ai * 128 + m * 16; const float rs = rsqrtf(ssq[row] * (1.f / QL) + EPS) * QSCALE; bf16* rowp = Q + (size_t)row * 1536 + pn * 256 + cw;
#pragma unroll
                for (int bj = 0; bj < 2; ++bj) { f32x4 v0 = acc[ai][bj][m][0] * rs, v1 = acc[ai][bj][m][1] * rs;
                    if ((8 * pn + 4 * bj + wc) % 3 == 2) rope8(v0, v1, cosT, sinT, row, fq);
                    *(u32x4*)(rowp + bj * 128) = pack8(v0, v1); }
                asm volatile("" ::: "memory"); }
    }
};
struct EpiKV {
    static constexpr bool PERM = true;
    bf16 *KN, *V; const float* ssq;
    __device__ __forceinline__ void operator()(f32x4 (&acc)[2][2][4][2], const Unit& u, int wr, int wc) const {
        int z_; asm volatile("v_mov_b32 %0, 0" : "=v"(z_)); const int lane_ = __builtin_amdgcn_mbcnt_hi(~0u, __builtin_amdgcn_mbcnt_lo(~0u, z_)), fr = lane_ & 15, fq = lane_ >> 4;
        const int row0 = u.pm * 256 + wr * 64 + fr, pn = u.pn, cw = wc * 32 + 8 * fq; bf16* base = (pn < 4) ? KN : V; const int ct = (pn & 3) * 256;
#pragma unroll
        for (int ai = 0; ai < 2; ++ai)
#pragma unroll
            for (int m = 0; m < 4; ++m) { const int row = row0 + ai * 128 + m * 16; const float rs = rsqrtf(ssq[row] * (1.f / KVL) + EPS); bf16* rowp = base + (size_t)row * 1024 + ct + cw;
#pragma unroll
                for (int bj = 0; bj < 2; ++bj) *(u32x4*)(rowp + bj * 128) = pack8(acc[ai][bj][m][0] * rs, acc[ai][bj][m][1] * rs);
                asm volatile("" ::: "memory"); }
    }
};
template <bool SECOND> struct EpiMerge {
    static constexpr bool PERM = true;
    bf16* MG; const bf16* SG; int sgoff;
    __device__ __forceinline__ void operator()(f32x4 (&acc)[2][2][4][2], const Unit& u, int wr, int wc) const {
        int z_; asm volatile("v_mov_b32 %0, 0" : "=v"(z_)); const int lane_ = __builtin_amdgcn_mbcnt_hi(~0u, __builtin_amdgcn_mbcnt_lo(~0u, z_)), fr = lane_ & 15, fq = lane_ >> 4;
        const int row0 = u.pm * 256 + wr * 64 + fr, col0 = u.pn * 256 + wc * 32 + 8 * fq;
#pragma unroll
        for (int ai = 0; ai < 2; ++ai)
#pragma unroll
            for (int m = 0; m < 4; ++m) { const int row = row0 + ai * 128 + m * 16; bf16* rowp = MG + (size_t)row * 1024 + col0; const bf16* sgp = SG + (size_t)row * 2048 + sgoff + col0;
#pragma unroll
                for (int bj = 0; bj < 2; ++bj) { const u32x4 g = *(const u32x4*)(sgp + bj * 128); f32x4 v0 = acc[ai][bj][m][0], v1 = acc[ai][bj][m][1];
                    v0[0] *= bflo(g.x); v0[1] *= bfhi(g.x); v0[2] *= bflo(g.y); v0[3] *= bfhi(g.y); v1[0] *= bflo(g.z); v1[1] *= bfhi(g.z); v1[2] *= bflo(g.w); v1[3] *= bfhi(g.w);
                    if (SECOND) { const u32x4 p = *(const u32x4*)(rowp + bj * 128);
                        v0[0] += bflo(p.x); v0[1] += bfhi(p.x); v0[2] += bflo(p.y); v0[3] += bfhi(p.y); v1[0] += bflo(p.z); v1[1] += bfhi(p.z); v1[2] += bflo(p.w); v1[3] += bfhi(p.w); }
                    *(u32x4*)(rowp + bj * 128) = pack8(v0, v1); } }
    }
};
struct EpiRes {
    static constexpr bool PERM = false;
    const float* base; float* out; const float* mod; int goff;
    __device__ __forceinline__ void operator()(f32x4 (&acc)[2][2][4][2], const Unit& u, int wr, int wc) const {
        int z_; asm volatile("v_mov_b32 %0, 0" : "=v"(z_)); const int lane_ = __builtin_amdgcn_mbcnt_hi(~0u, __builtin_amdgcn_mbcnt_lo(~0u, z_)), fr = lane_ & 15, fq = lane_ >> 4;
        const int row0 = u.pm * 256 + wr * 64 + fr, col0 = u.pn * 256 + wc * 32 + 4 * fq; const float* gate = mod + (u.pm >> 4) * 6144 + goff;
#pragma unroll
        for (int bj = 0; bj < 2; ++bj)
#pragma unroll
            for (int n = 0; n < 2; ++n) { const int col = col0 + bj * 128 + n * 16; const f32x4 gv = *(const f32x4*)(gate + col);
#pragma unroll
                for (int ai = 0; ai < 2; ++ai)
#pragma unroll
                    for (int m = 0; m < 4; ++m) { const size_t off = (size_t)(row0 + ai * 128 + m * 16) * 1024 + col; *(f32x4*)(out + off) = *(const f32x4*)(base + off) + gv * acc[ai][bj][m][n]; } }
    }
};
template <int CTRL> __device__ __forceinline__ float dpp_mov(float old, float src) { return __builtin_bit_cast(float, __builtin_amdgcn_update_dpp(__builtin_bit_cast(int, old), __builtin_bit_cast(int, src), CTRL, 0xf, 0xf, false)); }
struct EpiUp {
    static constexpr bool PERM = true;
    bf16* ACT; float* SIDE; const float *cw, *cb;
    __device__ __forceinline__ void operator()(f32x4 (&acc)[2][2][4][2], const Unit& u, int wr, int wc) const {
        int z_; asm volatile("v_mov_b32 %0, 0" : "=v"(z_)); const int lane_ = __builtin_amdgcn_mbcnt_hi(~0u, __builtin_amdgcn_mbcnt_lo(~0u, z_)), fr = lane_ & 15, fq = lane_ >> 4;
        const int row0 = u.pm * 256 + wr * 64 + fr, pn = u.pn, cwo = wc * 32 + 8 * fq;
        if (fr < 2 || fr >= 14) {
#pragma unroll
            for (int ai = 0; ai < 2; ++ai) { const int grp = (u.pm * 256 + ai * 128 + wr * 64) >> 6; const int m = (fr < 2) ? 0 : 3; const int slot = (fr < 2) ? fr : fr - 12;
                float* sp = SIDE + ((size_t)grp * 4 + slot) * NUP + pn * 256 + cwo;
#pragma unroll
                for (int bj = 0; bj < 2; ++bj)
#pragma unroll
                    for (int n = 0; n < 2; ++n) { const f32x4 v = (m == 0) ? acc[ai][bj][0][n] : acc[ai][bj][3][n]; *(f32x4*)(sp + bj * 128 + 4 * n) = v; } }
        }
#pragma unroll
        for (int n = 0; n < 2; ++n) {
            const int f0 = pn * 128 + cwo + 4 * n;
            f32x4 wg[3], wv[3];
#pragma unroll
            for (int k = 0; k < 3; ++k) { wg[k] = *(const f32x4*)(cw + k * NUP + f0); wv[k] = *(const f32x4*)(cw + k * NUP + DFF + f0); }
            const f32x4 bg = *(const f32x4*)(cb + f0), bv = *(const f32x4*)(cb + DFF + f0);
#pragma unroll
            for (int ai = 0; ai < 2; ++ai) {
                f32x4 pg = (f32x4){0.f, 0.f, 0.f, 0.f}, pv = pg;
#pragma unroll
                for (int m = 0; m < 4; ++m) { const f32x4 g = acc[ai][0][m][n], v = acc[ai][1][m][n]; f32x4 ug, uv;
#pragma unroll
                    for (int e = 0; e < 4; ++e) {
                        const float g1 = dpp_mov<0x111>(dpp_mov<0x121>(0.f, pg[e]), g[e]), g2 = dpp_mov<0x112>(dpp_mov<0x122>(0.f, pg[e]), g[e]);
                        const float v1 = dpp_mov<0x111>(dpp_mov<0x121>(0.f, pv[e]), v[e]), v2 = dpp_mov<0x112>(dpp_mov<0x122>(0.f, pv[e]), v[e]);
                        ug[e] = bg[e] + wg[2][e] * g[e] + wg[1][e] * g1 + wg[0][e] * g2; uv[e] = bv[e] + wv[2][e] * v[e] + wv[1][e] * v1 + wv[0][e] * v2; }
                    f32x4 o;
#pragma unroll
                    for (int e = 0; e < 4; ++e) o[e] = ug[e] * fsigmoid(ug[e]) * uv[e];
                    u32x2 w; w.x = cvt_pk_bf16(o[0], o[1]); w.y = cvt_pk_bf16(o[2], o[3]);
                    *(u32x2*)(ACT + (size_t)(row0 + ai * 128 + m * 16) * DFF + f0) = w;
                    pg = g; pv = v; }
            }
        }
    }
};
constexpr int NWAVES = 8;
constexpr int RING_OFF = 0, RING_BYTES = 131072;
constexpr int LDSCTL_OFF = RING_BYTES, MISC_OFF = LDSCTL_OFF + 320;
constexpr int LDS_BYTES = 147456;
struct Args { const float* in[27]; float* out; unsigned char* ws; int ph_lo, ph_hi; };
typedef const __attribute__((address_space(4))) Args* KArgs;
struct Frame {
    LAS unsigned char* lds; volatile LAS unsigned* MISC; unsigned char* ws; KArgs ka;
    int wave, vcu, G;
    float* out;
};
#define INP(i) (F.ka->in[i])
__device__ __forceinline__ int lane_id() { int z; asm volatile("v_mov_b32 %0, 0" : "=v"(z)); return __builtin_amdgcn_mbcnt_hi(~0u, __builtin_amdgcn_mbcnt_lo(~0u, z)); }

__device__ __forceinline__ void p0_transpose_item(const float* W, int K, int N, bf16* WT, int kb, int dst_row0, int src0, bool ilv, const float* kscale, LAS float* scr, int lane) {
    const int k0 = 64 * kb; const int sc = lane & 31; const int dn = ilv ? (2 * (sc & 15) + (sc >> 4)) : sc;
#pragma unroll 8
    for (int i = 0; i < 32; ++i) { const int kk = 2 * i + (lane >> 5); float v = W[(size_t)(k0 + kk) * N + src0 + sc]; if (kscale) v *= kscale[k0 + kk]; scr[kk * 33 + dn] = v; }
    LDS_WAIT(); asm volatile("" ::: "memory");
    const int c = lane & 7;
#pragma unroll
    for (int j = 0; j < 4; ++j) { const int n = (lane >> 3) + 8 * j; const LAS float* s = scr + (8 * c) * 33 + n;
        u32x4 o; o.x = cvt_pk_bf16(s[0 * 33], s[1 * 33]); o.y = cvt_pk_bf16(s[2 * 33], s[3 * 33]); o.z = cvt_pk_bf16(s[4 * 33], s[5 * 33]); o.w = cvt_pk_bf16(s[6 * 33], s[7 * 33]);
        *(u32x4*)(WT + (size_t)(dst_row0 + n) * K + k0 + 8 * c) = o; }
    LDS_WAIT(); asm volatile("" ::: "memory");
}
__device__ __forceinline__ void p0_prologue(Frame& F) {
    LAS float* scr = (LAS float*)(F.lds + RING_OFF + F.wave * 16384); const int lane = lane_id();
    const int gw = F.vcu * NWAVES + F.wave, NGW = F.G * NWAVES;
    constexpr int I_IN = 16 * 128, I_UQ = 6 * 48, I_UKV = 4 * 64, I_PR = 20 * 32, I_PM = 16 * 32, I_OUT = 16 * 32, I_UP = 16 * 176, I_DN = 44 * 32;
    constexpr int NITEMS = I_IN + I_UQ + I_UKV + I_PR + I_PM + I_OUT + I_UP + I_DN;
    for (int it = gw; it < NITEMS; it += NGW) {
        int r = it;
        if (r < I_IN) { const int nb = r % 128, kb = r / 128; if (nb >= 61 && nb < 64) continue; const int src0 = nb < 61 ? 32 * nb : 1952 + 32 * (nb - 64);
            p0_transpose_item(INP(6), DM, DIN, (bf16*)(F.ws + WS_WIN), kb, 32 * nb, src0, nb == 60, nullptr, scr, lane); continue; } r -= I_IN;
        if (r < I_UQ) { const int nb = r % 48, kb = r / 48; p0_transpose_item(INP(15), QL, 1536, (bf16*)(F.ws + WS_WUQ), kb, 32 * nb, 32 * nb, (nb % 3) == 2, INP(14), scr, lane); continue; } r -= I_UQ;
        if (r < I_UKV) { const int nb = r % 64, kb = r / 64; const int nb2 = nb & 31, hh = nb2 >> 1, half = nb2 & 1; const int src0 = 128 * hh + (nb >= 32 ? 64 : 0) + 32 * half;
            p0_transpose_item(INP(17), KVL, 2048, (bf16*)(F.ws + WS_WUKV), kb, 32 * nb, src0, false, INP(16), scr, lane); continue; } r -= I_UKV;
        if (r < I_PR) { const int nb = r % 32, kb = r / 32; p0_transpose_item(INP(18), DRNN, DM, (bf16*)(F.ws + WS_WPR), kb, 32 * nb, 32 * nb, false, nullptr, scr, lane); continue; } r -= I_PR;
        if (r < I_PM) { const int nb = r % 32, kb = r / 32; p0_transpose_item(INP(19), DM, DM, (bf16*)(F.ws + WS_WPM), kb, 32 * nb, 32 * nb, false, nullptr, scr, lane); continue; } r -= I_PM;
        if (r < I_OUT) { const int nb = r % 32, kb = r / 32; p0_transpose_item(INP(20), DM, DM, (bf16*)(F.ws + WS_WOUT), kb, 32 * nb, 32 * nb, false, nullptr, scr, lane); continue; } r -= I_OUT;
        if (r < I_UP) { const int nb = r % 176, kb = r / 176; const int j = nb >> 3, w = nb & 7; const int src0 = (w < 4) ? 128 * j + 32 * w : DFF + 128 * j + 32 * (w - 4);
            p0_transpose_item(INP(22), DM, NUP, (bf16*)(F.ws + WS_WUP), kb, 32 * nb, src0, false, nullptr, scr, lane); continue; } r -= I_UP;
        { const int nb = r % 32, kb = r / 32; p0_transpose_item(INP(25), DFF, DM, (bf16*)(F.ws + WS_WDN), kb, 32 * nb, 32 * nb, false, nullptr, scr, lane); }
    }
    float* mod = (float*)(F.ws + WS_CTL + CTL_MOD);
    for (int it = gw; it < 96 * 16; it += NGW) { const int cc = it % 96, ks = it / 96, col = cc * 64 + lane, k0 = ks * 64;
#pragma unroll
        for (int b = 0; b < 8; ++b) { const float cv = INP(1)[b * DM + k0 + lane]; scr[b * 64 + lane] = cv * fsigmoid(cv); }
        LDS_WAIT(); asm volatile("" ::: "memory");
        float a[8];
#pragma unroll
        for (int b = 0; b < 8; ++b) a[b] = (ks == 0) ? INP(4)[col] : 0.f;
#pragma unroll 8
        for (int k = 0; k < 64; ++k) { const float w = INP(3)[(size_t)(k0 + k) * 6144 + col];
#pragma unroll
            for (int b = 0; b < 8; ++b) a[b] += scr[b * 64 + k] * w; }
#pragma unroll
        for (int b = 0; b < 8; ++b) unsafeAtomicAdd(mod + b * 6144 + col, a[b]);
        LDS_WAIT(); asm volatile("" ::: "memory");
    }
    float* cosT = (float*)(F.ws + WS_COS); float* sinT = (float*)(F.ws + WS_SIN); const int* pos = (const int*)INP(2);
    for (int i = F.vcu * 512 + F.wave * 64 + lane; i < NT * 16; i += F.G * 512) { const int t = i >> 4, j = i & 15;
        const float inv = powf(10000.f, -(float)j / 16.f); const float ang = (float)pos[t] * inv;
        cosT[i] = cosf(ang); sinT[i] = sinf(ang); }
}

__device__ __forceinline__ void norm_rows_mod(Frame& F, const float* src, bf16* dst, const float* g, int soff, int hoff) {
    const int lane = lane_id(); const int gw = F.vcu * NWAVES + F.wave, NGW = F.G * NWAVES; const float* mod = (const float*)(F.ws + WS_CTL + CTL_MOD);
    for (int rb = gw; rb < NT / 16; rb += NGW) { const int b = rb >> 8; const float* mb = mod + b * 6144;
        f32x4 gg[4], sh[4];
#pragma unroll
        for (int j = 0; j < 4; ++j) { const int col = 4 * lane + 256 * j; const f32x4 gv = *(const f32x4*)(g + col), sc = *(const f32x4*)(mb + soff + col); gg[j] = gv * (sc + 1.0f); sh[j] = *(const f32x4*)(mb + hoff + col); }
        for (int r = 0; r < 16; ++r) { const size_t row = (size_t)rb * 16 + r; const f32x4* xr = (const f32x4*)(src + row * DM) + lane;
            f32x4 v[4]; float s = 0.f;
#pragma unroll
            for (int j = 0; j < 4; ++j) { v[j] = xr[64 * j]; s += sumsq4(v[j]); }
            const float rinv = rsqrtf(wave_sum(s) * (1.f / DM) + EPS);
            u32x2* o8 = (u32x2*)(dst + row * DM) + lane;
#pragma unroll
            for (int j = 0; j < 4; ++j) { const f32x4 y = v[j] * rinv * gg[j] + sh[j]; u32x2 w; w.x = cvt_pk_bf16(y[0], y[1]); w.y = cvt_pk_bf16(y[2], y[3]); o8[64 * j] = w; } }
    }
}
__device__ __forceinline__ void norm_rows_final(Frame& F, float* io, const float* g) {
    const int lane = lane_id(); const int gw = F.vcu * NWAVES + F.wave, NGW = F.G * NWAVES;
    f32x4 gg[4];
#pragma unroll
    for (int j = 0; j < 4; ++j) gg[j] = *(const f32x4*)(g + 4 * lane + 256 * j);
    for (int row = gw; row < NT; row += NGW) { f32x4* xr = (f32x4*)(io + (size_t)row * DM) + lane;
        f32x4 v[4]; float s = 0.f;
#pragma unroll
        for (int j = 0; j < 4; ++j) { v[j] = xr[64 * j]; s += sumsq4(v[j]); }
        const float rinv = rsqrtf(wave_sum(s) * (1.f / DM) + EPS);
#pragma unroll
        for (int j = 0; j < 4; ++j) xr[64 * j] = v[j] * rinv * gg[j]; }
}
__device__ __forceinline__ void ffn_fixup(Frame& F, bf16* ACT, const float* SIDE, const float* cw, const float* cb) {
    const int lane = lane_id(); const int gw = F.vcu * NWAVES + F.wave, NGW = F.G * NWAVES;
    for (int it = gw; it < 512 * 22; it += NGW) { const int grp = it / 22, j = it % 22, rs = lane >> 5, l = lane & 31, f0 = 128 * j + 4 * l;
        const float* s0 = SIDE + ((size_t)grp * 4) * NUP + 256 * j + 4 * l; const float* sp = s0 - (size_t)4 * NUP;
        const bool first = (grp & 63) == 0;
        const f32x4 z = (f32x4){0.f, 0.f, 0.f, 0.f};
        f32x4 cur[2], p1[2], p2[2];
#pragma unroll
        for (int h = 0; h < 2; ++h) { const int co = 128 * h;
            const f32x4 r0 = *(const f32x4*)(s0 + co), r1 = *(const f32x4*)(s0 + NUP + co);
            const f32x4 q63 = first ? z : *(const f32x4*)(sp + 3 * (size_t)NUP + co), q62 = first ? z : *(const f32x4*)(sp + 2 * (size_t)NUP + co);
            cur[h] = rs ? r1 : r0; p1[h] = rs ? r0 : q63; p2[h] = rs ? q63 : q62; }
        f32x4 u[2];
#pragma unroll
        for (int h = 0; h < 2; ++h) { const int fo = h * DFF + f0; u[h] = *(const f32x4*)(cb + fo) + *(const f32x4*)(cw + 2 * NUP + fo) * cur[h] + *(const f32x4*)(cw + NUP + fo) * p1[h] + *(const f32x4*)(cw + fo) * p2[h]; }
        f32x4 o;
#pragma unroll
        for (int e = 0; e < 4; ++e) o[e] = u[0][e] * fsigmoid(u[0][e]) * u[1][e];
        u32x2 w; w.x = cvt_pk_bf16(o[0], o[1]); w.y = cvt_pk_bf16(o[2], o[3]);
        *(u32x2*)(ACT + ((size_t)grp * 64 + rs) * DFF + f0) = w; }
}
__device__ __forceinline__ int crow(int r, int hi) { return (r & 3) + 8 * (r >> 2) + 4 * hi; }
namespace rnn {
constexpr int L_WG = 0, L_CW = 18432, L_CB = L_CW + 1024, L_TOT = L_CB + 256, L_END = L_TOT + 8192;
__device__ __forceinline__ void unit(Frame& F, int b, int n) {
    LAS unsigned char* L = F.lds; const int lane = lane_id(), wid = F.wave, tid = wid * 64 + lane, r32 = lane & 31, hi = lane >> 5;
    const bf16* XR = (const bf16*)(F.ws + WS_R2); bf16* YR = (bf16*)(F.ws + WS_R1); const int* pos = (const int*)INP(2) + b * SEQ;
    __syncthreads();
    { const float* wa = INP(9) + n * 4096; const float* wx = INP(11) + n * 4096; LAS bf16* wg = (LAS bf16*)(L + L_WG);
      for (int i = tid; i < 4096; i += 512) { const int d = i >> 6, e = i & 63; wg[e * 72 + d] = (bf16)(cvt_pk_bf16(wa[i], 0.f) & 0xffffu); wg[(64 + e) * 72 + d] = (bf16)(cvt_pk_bf16(wx[i], 0.f) & 0xffffu); }
      if (tid < 256) ((LAS float*)(L + L_CW))[tid] = INP(7)[(tid >> 6) * DRNN + 64 * n + (tid & 63)];
      if (tid < 64) ((LAS float*)(L + L_CB))[tid] = INP(8)[64 * n + tid]; }
    __syncthreads();
    const LAS unsigned char* wgL = L + L_WG + (r32 * 72 + 8 * hi) * 2;
    float cba[2], cbx[2], ckc[2], carry[2];
#pragma unroll
    for (int nt = 0; nt < 2; ++nt) { const int ch = 64 * n + 32 * nt + r32; cba[nt] = INP(10)[ch]; cbx[nt] = INP(12)[ch]; const float Lp = INP(13)[ch]; ckc[nt] = -8.f * ((-Lp > 20.f) ? -Lp : log1pf(expf(-Lp))); carry[nt] = 0.f; }
    const LAS float* cwL = (const LAS float*)(L + L_CW); const LAS float* cbL = (const LAS float*)(L + L_CB);
    for (int chunk = 0; chunk < 16; ++chunk) {
        const int tok0 = chunk * 256 + wid * 32, tA = tok0 + r32;
        const unsigned long long rmask = __ballot(pos[tA] == 0);
        bf16x8 A[4];
#pragma unroll
        for (int kk = 0; kk < 4; ++kk) { const int c0 = 16 * kk + 8 * hi;
            f32x4 a0 = *(const LAS f32x4*)(cbL + c0), a1 = *(const LAS f32x4*)(cbL + c0 + 4);
#pragma unroll
            for (int tap = 0; tap < 4; ++tap) { const int tt = tA - 3 + tap; const int ttc = tt < 0 ? 0 : tt;
                u32x4 xv = *(const u32x4*)(XR + (size_t)(b * SEQ + ttc) * DRNN + 64 * n + c0); if (tt < 0) xv = (u32x4){0u, 0u, 0u, 0u};
                const f32x4 w0 = *(const LAS f32x4*)(cwL + tap * 64 + c0), w1 = *(const LAS f32x4*)(cwL + tap * 64 + c0 + 4);
                a0[0] += w0[0] * bflo(xv.x); a0[1] += w0[1] * bfhi(xv.x); a0[2] += w0[2] * bflo(xv.y); a0[3] += w0[3] * bfhi(xv.y);
                a1[0] += w1[0] * bflo(xv.z); a1[1] += w1[1] * bfhi(xv.z); a1[2] += w1[2] * bflo(xv.w); a1[3] += w1[3] * bfhi(xv.w); }
            A[kk] = __builtin_bit_cast(bf16x8, pack8(a0, a1)); }
        LAS float* tot = (LAS float*)(L + L_TOT) + (chunk & 1) * 1024;
        float aa[2][16], bb[2][16], As[2][8], Bs[2][8];
#pragma unroll
        for (int nt = 0; nt < 2; ++nt) {
            f32x16 za = {}, zx = {}, xc = {};
#pragma unroll
            for (int kk = 0; kk < 4; ++kk) {
                const int dd = 32 * nt + r32 - 16 * kk - 8 * hi; u32x4 iw;
                iw.x = dd == 0 ? 0x3F80u : dd == 1 ? 0x3F800000u : 0u; iw.y = dd == 2 ? 0x3F80u : dd == 3 ? 0x3F800000u : 0u; iw.z = dd == 4 ? 0x3F80u : dd == 5 ? 0x3F800000u : 0u; iw.w = dd == 6 ? 0x3F80u : dd == 7 ? 0x3F800000u : 0u;
                const bf16x8 fa = *(const LAS bf16x8*)(wgL + (32 * nt * 72 + 16 * kk) * 2), fx = *(const LAS bf16x8*)(wgL + ((64 + 32 * nt) * 72 + 16 * kk) * 2);
                za = __builtin_amdgcn_mfma_f32_32x32x16_bf16(A[kk], fa, za, 0, 0, 0);
                zx = __builtin_amdgcn_mfma_f32_32x32x16_bf16(A[kk], fx, zx, 0, 0, 0);
                xc = __builtin_amdgcn_mfma_f32_32x32x16_bf16(A[kk], __builtin_bit_cast(bf16x8, iw), xc, 0, 0, 0); }
#pragma unroll
            for (int r = 0; r < 16; ++r) {
                const float rg = fsigmoid(za[r] + cba[nt]), ig = fsigmoid(zx[r] + cbx[nt]); const float la = ckc[nt] * rg; float a = __builtin_amdgcn_exp2f(la * LOG2E);
                const float x2 = 2.f * la; const float ser = -x2 * (1.f + x2 * (0.5f + x2 * (0.16666667f + x2 * (0.041666668f + x2 * (0.0083333338f + x2 * 0.0013888889f)))));
                float em = (x2 > -0.25f) ? ser : (1.f - a * a); float mult = __builtin_amdgcn_sqrtf(em);
                if ((rmask >> crow(r, hi)) & 1ull) { a = 0.f; mult = 1.f; }
                aa[nt][r] = a; bb[nt][r] = mult * (ig * xc[r]); }
#pragma unroll
            for (int g = 0; g < 4; ++g) { const float a0 = aa[nt][4 * g], a1 = aa[nt][4 * g + 1], a2 = aa[nt][4 * g + 2], a3 = aa[nt][4 * g + 3];
                const float Ag = (a0 * a1) * (a2 * a3), Bg = ((bb[nt][4 * g] * a1 + bb[nt][4 * g + 1]) * a2 + bb[nt][4 * g + 2]) * a3 + bb[nt][4 * g + 3];
                const float Ao = __shfl_xor(Ag, 32), Bo = __shfl_xor(Bg, 32);
                As[nt][2 * g] = hi ? Ao : Ag; Bs[nt][2 * g] = hi ? Bo : Bg; As[nt][2 * g + 1] = hi ? Ag : Ao; Bs[nt][2 * g + 1] = hi ? Bg : Bo; }
            float At = 1.f, Bt = 0.f;
#pragma unroll
            for (int s = 0; s < 8; ++s) { Bt = As[nt][s] * Bt + Bs[nt][s]; At *= As[nt][s]; }
            if (hi == 0) *(LAS f32x2*)(tot + ((wid * 2 + nt) * 32 + r32) * 2) = (f32x2){At, Bt};
        }
        __syncthreads();
#pragma unroll
        for (int nt = 0; nt < 2; ++nt) {
            float hin = carry[nt], hh = carry[nt];
#pragma unroll
            for (int j = 0; j < 8; ++j) { const f32x2 ab = *(const LAS f32x2*)(tot + ((j * 2 + nt) * 32 + r32) * 2); if (j == wid) hin = hh; hh = ab.x * hh + ab.y; }
            carry[nt] = hh;
            float hseg[4]; float h = hin;
#pragma unroll
            for (int s = 0; s < 8; ++s) { if ((s & 1) == hi) hseg[s >> 1] = h; h = As[nt][s] * h + Bs[nt][s]; }
#pragma unroll
            for (int g = 0; g < 4; ++g) { float hv = hseg[g];
#pragma unroll
                for (int q = 0; q < 4; ++q) { const int r = 4 * g + q; hv = aa[nt][r] * hv + bb[nt][r];
                    YR[(size_t)(b * SEQ + tok0 + crow(r, hi)) * DRNN + 64 * n + 32 * nt + r32] = (bf16)(cvt_pk_bf16(hv, 0.f) & 0xffffu); } }
        }
    }
}
}

namespace att {
constexpr int KSLOT = 12288, VSLOT = 8192, NS = 3;
constexpr int L_K = 0, L_V = NS * KSLOT, L_WS = L_V + NS * VSLOT, L_OST = L_WS + NWAVES * 256, L_END = L_OST + NWAVES * 4096;
__device__ __forceinline__ void glds16(const void* gsrc, unsigned lds_dst) { unsigned keep;
    asm volatile("s_mov_b32 %0, m0\n\ts_mov_b32 m0, %2\n\ts_nop 0\n\tglobal_load_lds_dwordx4 %1, off\n\ts_mov_b32 m0, %0" : "=&s"(keep) : "v"(gsrc), "s"(lds_dst) : "memory"); }
__device__ __forceinline__ unsigned cvtpk(float lo, float hi) { return cvt_pk_bf16(lo, hi); }
#define ATT_WAIT_BAR(N) asm volatile("s_waitcnt vmcnt(" #N ") lgkmcnt(0)\n\ts_barrier" ::: "memory")
__device__ __forceinline__ void unit(Frame& F, int b, int h, int qb) {
    LAS unsigned char* shm = F.lds; const int lane = lane_id(), wid = F.wave, r32 = lane & 31, hi = lane >> 5;
    const bf16* Q = (const bf16*)(F.ws + WS_Q); const bf16* KN = (const bf16*)(F.ws + WS_KN); const bf16* KR = (const bf16*)(F.ws + WS_KR); const bf16* V = (const bf16*)(F.ws + WS_V); bf16* O = (bf16*)(F.ws + WS_R2);
    const long rowbase = (long)b * SEQ; const int q0 = qb * 256;
    const bf16* Qw = Q + (rowbase + q0 + wid * 32) * 1536 + h * 96;
    const bf16* ksrc = KN + (rowbase + lane) * 1024 + h * 64 + wid * 8;
    const bf16* rsrc = KR + (rowbase + lane) * 32 + (wid & 3) * 8;
    const bf16* vsrc = V + (rowbase + 16 * (wid & 3) + (lane >> 2)) * 1024 + h * 64 + (wid >> 2) * 32 + (lane & 3) * 8;
    const unsigned lds0 = (unsigned)(size_t)shm;
    const unsigned kdst = lds0 + L_K + wid * 1024, rdst = lds0 + L_K + (8 + (wid & 3)) * 1024, vdst = lds0 + L_V + wid * 1024;
#define ATT_DMA(t, s) do { glds16(ksrc + (long)(t) * 65536, (unsigned)__builtin_amdgcn_readfirstlane(kdst + (s) * KSLOT)); glds16(rsrc + (long)(t) * 2048, (unsigned)__builtin_amdgcn_readfirstlane(rdst + (s) * KSLOT)); \
        glds16(vsrc + (long)(t) * 65536, (unsigned)__builtin_amdgcn_readfirstlane(vdst + (s) * VSLOT)); } while (0)
    const int NTL = 4 * (qb + 1);
    ATT_DMA(0, 0); ATT_DMA(1, 1);
    bf16x8 qr[6];
#pragma unroll
    for (int d0 = 0; d0 < 6; ++d0) qr[d0] = *(const bf16x8*)(Qw + (long)r32 * 1536 + d0 * 16 + hi * 8);
    LAS float* wsf = (LAS float*)(shm + L_WS) + wid * 64;
    float mrun = -1e30f, lsum = 0.f; f32x16 o[2]; o[0] = f32x16{}; o[1] = f32x16{};
    const int qrel = wid * 32 + r32;
    int slot = 0;
    for (int t = 0; t < NTL; ++t) {
        if (t + 1 < NTL) ATT_WAIT_BAR(3); else ATT_WAIT_BAR(0);
        if (t + 2 < NTL) { const int s2 = slot >= 1 ? slot - 1 : 2; ATT_DMA(t + 2, s2); }
        f32x16 p0 = {}, p1 = {};
        { const LAS unsigned char* kb = shm + L_K + slot * KSLOT + hi * 1024 + r32 * 16;
#pragma unroll
          for (int d0 = 0; d0 < 6; ++d0) { const bf16x8 b0 = *(const LAS bf16x8*)(kb + d0 * 2048), b1 = *(const LAS bf16x8*)(kb + d0 * 2048 + 512);
              p0 = __builtin_amdgcn_mfma_f32_32x32x16_bf16(b0, qr[d0], p0, 0, 0, 0); p1 = __builtin_amdgcn_mfma_f32_32x32x16_bf16(b1, qr[d0], p1, 0, 0, 0); } }
        const int jb = t - (NTL - 4);
        if (jb >= 0) { const int kb0 = 64 * jb + 4 * hi;
#pragma unroll
            for (int r = 0; r < 16; ++r) { const int kv = kb0 + (r & 3) + 8 * (r >> 2); if (kv > qrel) p0[r] = -INFINITY; if (kv + 32 > qrel) p1[r] = -INFINITY; } }
        float rm = p0[0];
#pragma unroll
        for (int r = 1; r < 16; ++r) rm = fmaxf(rm, p0[r]);
#pragma unroll
        for (int r = 0; r < 16; ++r) rm = fmaxf(rm, p1[r]);
        rm = fmaxf(rm, __shfl_xor(rm, 32));
        const float mn = fmaxf(mrun, rm); const float alpha = __builtin_amdgcn_exp2f(mrun - mn); const bool grew = mn > mrun; mrun = mn;
        float sacc = 0.f;
#pragma unroll
        for (int r = 0; r < 16; ++r) { p0[r] = __builtin_amdgcn_exp2f(p0[r] - mn); p1[r] = __builtin_amdgcn_exp2f(p1[r] - mn); sacc += p0[r] + p1[r]; }
        lsum = lsum * alpha + sacc;
        if (__any(grew)) { if (hi == 0) wsf[r32] = alpha; LDS_WAIT();
#pragma unroll
            for (int r = 0; r < 16; ++r) { const float f = wsf[crow(r, hi)]; o[0][r] *= f; o[1][r] *= f; } }
        u32x4 pw0, pw1, pw2, pw3;
        pw0 = (u32x4){cvtpk(p0[0], p0[1]), cvtpk(p0[2], p0[3]), cvtpk(p0[4], p0[5]), cvtpk(p0[6], p0[7])}; pw1 = (u32x4){cvtpk(p0[8], p0[9]), cvtpk(p0[10], p0[11]), cvtpk(p0[12], p0[13]), cvtpk(p0[14], p0[15])};
        pw2 = (u32x4){cvtpk(p1[0], p1[1]), cvtpk(p1[2], p1[3]), cvtpk(p1[4], p1[5]), cvtpk(p1[6], p1[7])}; pw3 = (u32x4){cvtpk(p1[8], p1[9]), cvtpk(p1[10], p1[11]), cvtpk(p1[12], p1[13]), cvtpk(p1[14], p1[15])};
        { const int vb = (int)(lds0 + L_V + slot * VSLOT) + ((lane >> 4) & 1) * 32 + (lane & 3) * 8 + (4 * hi + ((lane & 15) >> 2)) * 64;
#pragma unroll
          for (int d0 = 0; d0 < 2; ++d0) { s16x4 lo[4], hi4[4];
#pragma unroll
              for (int ks = 0; ks < 4; ++ks) {
                  asm volatile("ds_read_b64_tr_b16 %0,%1 offset:%c2" : "=&v"(lo[ks]) : "v"(vb), "i"(d0 * 4096 + ks * 1024) : "memory");
                  asm volatile("ds_read_b64_tr_b16 %0,%1 offset:%c2" : "=&v"(hi4[ks]) : "v"(vb), "i"(d0 * 4096 + ks * 1024 + 512) : "memory"); }
              asm volatile("s_waitcnt lgkmcnt(0)" ::: "memory"); __builtin_amdgcn_sched_barrier(0);
#define ATT_PK(k) (bf16x8){lo[k][0], lo[k][1], lo[k][2], lo[k][3], hi4[k][0], hi4[k][1], hi4[k][2], hi4[k][3]}
              o[d0] = __builtin_amdgcn_mfma_f32_32x32x16_bf16(__builtin_bit_cast(bf16x8, pw0), ATT_PK(0), o[d0], 0, 0, 0);
              o[d0] = __builtin_amdgcn_mfma_f32_32x32x16_bf16(__builtin_bit_cast(bf16x8, pw1), ATT_PK(1), o[d0], 0, 0, 0);
              o[d0] = __builtin_amdgcn_mfma_f32_32x32x16_bf16(__builtin_bit_cast(bf16x8, pw2), ATT_PK(2), o[d0], 0, 0, 0);
              o[d0] = __builtin_amdgcn_mfma_f32_32x32x16_bf16(__builtin_bit_cast(bf16x8, pw3), ATT_PK(3), o[d0], 0, 0, 0);
#undef ATT_PK
          } }
        slot = slot == 2 ? 0 : slot + 1;
    }
    lsum += __shfl_xor(lsum, 32);
    if (hi == 0) wsf[32 + r32] = lsum; LDS_WAIT();
    float rli[16];
#pragma unroll
    for (int r = 0; r < 16; ++r) rli[r] = __builtin_amdgcn_rcpf(wsf[32 + crow(r, hi)]);
    bf16* Ow = O + (rowbase + q0 + wid * 32) * 1024 + h * 64;
    { LAS bf16* stg = (LAS bf16*)(shm + L_OST) + wid * 2048;
#pragma unroll
      for (int r = 0; r < 16; ++r) { const int orow = crow(r, hi);
#pragma unroll
          for (int d0 = 0; d0 < 2; ++d0) stg[orow * 64 + d0 * 32 + r32] = (bf16)(cvt_pk_bf16(o[d0][r] * rli[r], 0.f) & 0xffffu); }
      LDS_WAIT();
#pragma unroll
      for (int i = 0; i < 4; ++i) { const int row = i * 8 + (lane >> 3), ch = lane & 7; const u32x4 v = *(const LAS u32x4*)(stg + row * 64 + ch * 8); *(u32x4*)(Ow + (long)row * 1024 + ch * 8) = v; } }
    asm volatile("s_waitcnt lgkmcnt(0)\n\ts_barrier" ::: "memory");
#undef ATT_DMA
}
#undef ATT_WAIT_BAR
}
#ifdef DBG_STOP_AFTER
__global__ void dbg_dump_k(float* out, unsigned char* ws, int stage) {
    const size_t NOUT = (size_t)NT * 1024; const size_t nthr = (size_t)gridDim.x * blockDim.x;
    for (size_t j = (size_t)blockIdx.x * blockDim.x + threadIdx.x; j < NOUT; j += nthr) {
        float a = 0.f;
        auto addb = [&](const void* p, size_t n) { const bf16* q = (const bf16*)p; for (size_t i = j; i < n; i += NOUT) a += __uint_as_float((unsigned)q[i] << 16); };
        auto addf = [&](const void* p, size_t n) { const float* q = (const float*)p; for (size_t i = j; i < n; i += NOUT) a += q[i]; };
        if (stage == 0) { addb(ws + WS_WIN, (size_t)35 * MiB / 2); addf(ws + WS_COS, (size_t)NT * 16); addf(ws + WS_SIN, (size_t)NT * 16); addf(ws + WS_CTL + CTL_MOD, 8 * 6144); }
        else if (stage == 1) { addb(ws + WS_R1, (size_t)NT * 1024); }
        else if (stage == 2) { const unsigned w = ((const unsigned*)out)[j]; a = __uint_as_float(w << 16) + __uint_as_float(w & 0xffff0000u);
            addb(ws + WS_R2, (size_t)NT * 1280); addb(ws + WS_LAT, (size_t)NT * 768); addb(ws + WS_KR, (size_t)NT * 32); addf(ws + WS_CTL + CTL_SSQQ, NT); addf(ws + WS_CTL + CTL_SSQKV, NT); }
        else if (stage == 20) { const unsigned w = ((const unsigned*)out)[j]; a = __uint_as_float(w << 16) + __uint_as_float(w & 0xffff0000u); }
        else if (stage == 24) { addb(ws + WS_Q, (size_t)NT * 2048); }
        else if (stage == 21) { addb(ws + WS_R2, (size_t)NT * 1280); }
        else if (stage == 22) { addb(ws + WS_LAT, (size_t)NT * 768); addb(ws + WS_KR, (size_t)NT * 32); }
        else if (stage == 23) { addf(ws + WS_CTL + CTL_SSQQ, NT); addf(ws + WS_CTL + CTL_SSQKV, NT); }
        else if (stage == 3) { addb(ws + WS_R1, (size_t)NT * 1280); addb(ws + WS_Q, (size_t)NT * 1536); addb(ws + WS_KN, (size_t)NT * 1024); addb(ws + WS_V, (size_t)NT * 1024); }
        else if (stage == 4) { addb(ws + WS_R2, (size_t)NT * 1024); }
        else if (stage == 5) { addb(ws + WS_Q, (size_t)NT * 1024); }
        else if (stage == 7) { addb(ws + WS_R1, (size_t)NT * 1024); }
        else if (stage == 8) { addb(ws + WS_Q, (size_t)NT * 2816); addf(ws + WS_R2, (size_t)512 * 4 * 5632); }
        else if (stage == 9) { addb(ws + WS_Q, (size_t)NT * 2816); }
        else continue;
        out[j] = a;
    }
}
#endif
constexpr int N_PHASES = 12;
#ifndef MK_N_LAUNCHES
#define MK_N_LAUNCHES 1
#endif
__global__ void __launch_bounds__(NWAVES * 64, 2) mk_fwd(Args args) {
    extern __shared__ __attribute__((aligned(16))) unsigned char lds_raw[];
    Frame F;
    F.ka = (KArgs)__builtin_amdgcn_kernarg_segment_ptr();
    F.lds = (LAS unsigned char*)lds_raw; F.MISC = (volatile LAS unsigned*)(F.lds + MISC_OFF); F.ws = args.ws;
    F.wave = __builtin_amdgcn_readfirstlane(threadIdx.x >> 6);
    F.G = gridDim.x; { const int bx = blockIdx.x; F.vcu = (F.G % 8 == 0) ? (bx % 8) * (F.G / 8) + bx / 8 : bx; }
    F.out = args.out;
    for (int u = threadIdx.x; u < (LDS_BYTES - LDSCTL_OFF) / 4; u += NWAVES * 64) ((LAS unsigned*)(F.lds + LDSCTL_OFF))[u] = 0u;
    __syncthreads();
    unsigned char* ws = args.ws;
    XcdBarrier bar; bar.bar = (unsigned*)(ws + WS_CTL + CTL_BAR); bar.x = 0; bar.st = nullptr;
    if (MK_N_LAUNCHES == 1) bar = xcd_barrier_post((unsigned*)(ws + WS_CTL + CTL_BAR), F.MISC + 8);
    const int lo = args.ph_lo, hi = args.ph_hi;
#ifndef MK_PHASE_MASK
#define MK_PHASE_MASK 0xfff
#endif
#define IN(k) (((MK_PHASE_MASK >> (k)) & 1) && lo <= (k) && (k) < hi)
#define SEAM(k) do { if (IN(k) && IN((k) + 1)) xcd_barrier(bar); } while (0)
    bf16* WIN = (bf16*)(ws + WS_WIN); bf16* WUQ = (bf16*)(ws + WS_WUQ); bf16* WUKV = (bf16*)(ws + WS_WUKV); bf16* WPR = (bf16*)(ws + WS_WPR); bf16* WPM = (bf16*)(ws + WS_WPM);
    bf16* WOUT = (bf16*)(ws + WS_WOUT); bf16* WUP = (bf16*)(ws + WS_WUP); bf16* WDN = (bf16*)(ws + WS_WDN);
    float* cosT = (float*)(ws + WS_COS); float* sinT = (float*)(ws + WS_SIN);
    float* mod = (float*)(ws + WS_CTL + CTL_MOD); float* ssq_q = (float*)(ws + WS_CTL + CTL_SSQQ); float* ssq_kv = (float*)(ws + WS_CTL + CTL_SSQKV);
    bf16* R1 = (bf16*)(ws + WS_R1); bf16* R2 = (bf16*)(ws + WS_R2); bf16* LAT = (bf16*)(ws + WS_LAT); bf16* QB = (bf16*)(ws + WS_Q); bf16* KNB = (bf16*)(ws + WS_KN); bf16* VB = (bf16*)(ws + WS_V); bf16* KRB = (bf16*)(ws + WS_KR);
#ifdef DBG_SG_IN_WS
    bf16* SG = (bf16*)(ws + WS_Q);
#else
    bf16* SG = (bf16*)F.out;
#endif
    bf16* MG = QB; bf16* ACT = QB; float* SIDE = (float*)R2;
    LAS unsigned char* ring = F.lds + RING_OFF;

    if (IN(0)) { p0_prologue(F); } SEAM(0);
    if (IN(1)) { norm_rows_mod(F, INP(0), R1, INP(5), 1024, 0); } SEAM(1);
    if (IN(2)) { pg8::Gemm g{R1, WIN, DM, DM, DM}; pg8::StaticOrder S; S.init(NT, 4096, F.G, (int)blockIdx.x);
        EpiIn E{R2, LAT, KRB, SG, ssq_q, ssq_kv, cosT, sinT};
        pg8::gemm_phase<EpiIn, pg8::StaticOrder, true, true>(ring, g, S, E, F.wave); } SEAM(2);
    if (IN(3)) {
#ifndef NO_RNN
        for (int u = F.vcu; u < NB * 20; u += F.G) rnn::unit(F, u / 20, u % 20);
        __syncthreads();
#endif
#ifndef NO_QKV
#ifndef NO_Q
        { pg8::Gemm g{LAT, WUQ, 768, QL, QL}; pg8::StaticOrder S; S.init(NT, 1536, F.G, (int)blockIdx.x); EpiQ E{QB, ssq_q, cosT, sinT};
          pg8::gemm_phase<EpiQ, pg8::StaticOrder, true, true>(ring, g, S, E, F.wave); }
#endif
#ifndef NO_KV
        { pg8::Gemm g{LAT + QL, WUKV, 768, KVL, KVL}; pg8::StaticOrder S; S.init(NT, 2048, F.G, (int)blockIdx.x); EpiKV E{KNB, VB, ssq_kv};
          pg8::gemm_phase<EpiKV, pg8::StaticOrder, true, true>(ring, g, S, E, F.wave); }
#endif
#endif
    } SEAM(3);
    if (IN(4)) {
        for (int idx = F.vcu; idx < 2048; idx += F.G) { const int v = idx & 255, i = idx >> 8, bh = v >> 1, s = v & 1; const int qb = 2 * i + ((i & 1) ? 1 - s : s);
            att::unit(F, bh >> 4, bh & 15, qb); }
    } SEAM(4);
    if (IN(5)) {
        { pg8::Gemm g{R1, WPR, DRNN, DRNN, DRNN}; pg8::StaticOrder S; S.init(NT, DM, F.G, (int)blockIdx.x); EpiMerge<false> E{MG, SG, 0};
          pg8::gemm_phase<EpiMerge<false>, pg8::StaticOrder, true, true>(ring, g, S, E, F.wave); }
#ifndef DBG_NO_MERGE_B
        { pg8::Gemm g{R2, WPM, DM, DM, DM}; pg8::StaticOrder S; S.init(NT, DM, F.G, (int)blockIdx.x); EpiMerge<true> E{MG, SG, 1024};
          pg8::gemm_phase<EpiMerge<true>, pg8::StaticOrder, true, true>(ring, g, S, E, F.wave); }
#endif
    } SEAM(5);
    if (IN(6)) { pg8::Gemm g{MG, WOUT, DM, DM, DM}; pg8::StaticOrder S; S.init(NT, DM, F.G, (int)blockIdx.x); EpiRes E{INP(0), F.out, mod, 2048};
        pg8::gemm_phase<EpiRes, pg8::StaticOrder, true, true>(ring, g, S, E, F.wave); } SEAM(6);
    if (IN(7)) { norm_rows_mod(F, F.out, R1, INP(21), 4096, 3072); } SEAM(7);
    if (IN(8)) { pg8::Gemm g{R1, WUP, DM, DM, DM}; pg8::StaticOrder S; S.init(NT, NUP, F.G, (int)blockIdx.x); EpiUp E{ACT, SIDE, INP(23), INP(24)};
        pg8::gemm_phase<EpiUp, pg8::StaticOrder, true, true>(ring, g, S, E, F.wave); } SEAM(8);
    if (IN(9)) { ffn_fixup(F, ACT, SIDE, INP(23), INP(24)); } SEAM(9);
    if (IN(10)) { pg8::Gemm g{ACT, WDN, DFF, DFF, DFF}; pg8::StaticOrder S; S.init(NT, DM, F.G, (int)blockIdx.x); EpiRes E{F.out, F.out, mod, 5120};
        pg8::gemm_phase<EpiRes, pg8::StaticOrder, true, true>(ring, g, S, E, F.wave); } SEAM(10);
    if (IN(11)) { norm_rows_final(F, F.out, INP(26)); }
#undef IN
#undef SEAM
}

extern "C" void kernel_launch(void* const* d_in, const int* in_sizes, int n_in, void* d_out, int out_size, void* d_ws, size_t ws_size, hipStream_t stream) {
    static int grid = 0;
    if (grid == 0) {
        if (n_in != 27 || in_sizes[0] != NT * DM || out_size != NT * DM || ws_size < WS_END) { fprintf(stderr, "kernel_launch: unexpected shapes (n_in %d, in0 %d, out %d, ws %zu); nothing launched\n", n_in, n_in > 0 ? in_sizes[0] : -1, out_size, ws_size); grid = -1; return; }
        int dev = 0, cus = 0, per_cu = 0;
        if (hipGetDevice(&dev) != hipSuccess || hipDeviceGetAttribute(&cus, hipDeviceAttributeMultiprocessorCount, dev) != hipSuccess) { grid = -1; return; }
        if (hipFuncSetAttribute((const void*)mk_fwd, hipFuncAttributeMaxDynamicSharedMemorySize, LDS_BYTES) != hipSuccess) { fprintf(stderr, "kernel_launch: hipFuncSetAttribute failed\n"); grid = -1; return; }
        if (hipOccupancyMaxActiveBlocksPerMultiprocessor(&per_cu, (const void*)mk_fwd, NWAVES * 64, LDS_BYTES) != hipSuccess || per_cu < 1) { fprintf(stderr, "kernel_launch: occupancy query says %d blocks/CU\n", per_cu); per_cu = 1; }
        (void)hipGetLastError();
        grid = cus;
    }
    if (grid < 0) return;
    (void)hipMemsetAsync((char*)d_ws + WS_CTL, 0, CTL_ZERO_BYTES, stream);
    Args a{};
    for (int i = 0; i < 27; ++i) a.in[i] = (const float*)d_in[i];
    a.out = (float*)d_out; a.ws = (unsigned char*)d_ws;
#ifdef DBG_STOP_AFTER
#ifndef DBG_STAGE
#define DBG_STAGE DBG_STOP_AFTER
#endif
    for (int p = 0; p <= DBG_STOP_AFTER; ++p) { a.ph_lo = p; a.ph_hi = p + 1; hipLaunchKernelGGL(mk_fwd, dim3(grid), dim3(NWAVES * 64), LDS_BYTES, stream, a); }
    hipLaunchKernelGGL(dbg_dump_k, dim3(2048), dim3(256), 0, stream, (float*)d_out, (unsigned char*)d_ws, (int)DBG_STAGE);
#elif MK_N_LAUNCHES == 1
    a.ph_lo = 0; a.ph_hi = N_PHASES;
    hipLaunchKernelGGL(mk_fwd, dim3(grid), dim3(NWAVES * 64), LDS_BYTES, stream, a);
#else
    for (int p = 0; p < N_PHASES; ++p) { a.ph_lo = p; a.ph_hi = p + 1; hipLaunchKernelGGL(mk_fwd, dim3(grid), dim3(NWAVES * 64), LDS_BYTES, stream, a); }
#endif
}
```

```cpp
#include <hip/hip_runtime.h>
#include <cstdio>
#include <cstdint>
#include <cmath>
namespace pg8 {
#define PG8_LAS __attribute__((address_space(3)))
typedef unsigned short bf16_t;
typedef short bf16x8 __attribute__((ext_vector_type(8)));
typedef float f32x4 __attribute__((ext_vector_type(4)));
typedef float f32x2 __attribute__((ext_vector_type(2)));
typedef unsigned u32x4 __attribute__((ext_vector_type(4)));
typedef unsigned u32x2 __attribute__((ext_vector_type(2)));
constexpr int BM = 256, BK = 64, HALF = 128, HTB = HALF * BK * 2  , STAGE_BYTES = 8 * HTB, NXCD = 8, WGM = 8;

__host__ __device__ __forceinline__ int lds_byte(int r, int c) { const int st = (r >> 4) * 2 + (c >> 5), rr = r & 15, cc = c & 31, ob = rr * 64 + cc * 2; return st * 1024 + (ob ^ (((ob >> 9) & 1) << 5)); }
__host__ __device__ __forceinline__ void stage_rc(int b, int& R, int& C) { const int st = b / 1024, sb = b % 1024, swz = sb ^ (((sb >> 9) & 1) << 5); R = (st >> 1) * 16 + swz / 64; C = (st & 1) * 32 + (swz % 64) / 2; }
__host__ __device__ __forceinline__ int perm32(int rho) { const int n = rho >> 4, i = rho & 15; return 8 * (i >> 2) + 4 * n + (i & 3); }

struct Unit { int pm, pn; };
struct Gemm { const bf16_t* A; const bf16_t* Bt; int lda, ldb, K; };

struct StaticOrder {
    int nM, nN, nwg, G, c;
    __host__ __device__ void init(int M, int N, int G_, int c_) { nM = M / BM; nN = N / BM; nwg = nM * nN; G = G_; c = c_; }
    __host__ __device__ bool next(int i, Unit& u) const {
        const long L = (long)i * G + c; if (L >= nwg) return false;
        int wgid = (int)L; { const int q = nwg / NXCD, r = nwg % NXCD, xcd = wgid % NXCD, off = wgid / NXCD; wgid = (xcd < r ? xcd * (q + 1) : r * (q + 1) + (xcd - r) * q) + off; }
        const int nig = WGM * nN, gid = wgid / nig, fm = gid * WGM, gsz = (nM - fm) < WGM ? (nM - fm) : WGM;
        u.pm = fm + ((wgid % nig) % gsz); u.pn = (wgid % nig) / gsz; return true;
    }
};
typedef __bf16 bf16x2_t __attribute__((ext_vector_type(2)));
__device__ __forceinline__ unsigned cvt_pk_bf16(float lo, float hi) { f32x2 v = {lo, hi}; bf16x2_t b = __builtin_convertvector(v, bf16x2_t); return __builtin_bit_cast(unsigned, b); }

template <class Epi, class Sched, bool ALIGN_EPI = false, bool SP2 = false>
__device__ __forceinline__ void gemm_phase(PG8_LAS unsigned char* lds, const Gemm g, const Sched& S, const Epi& E, const int wid_) {
    int z_; asm volatile("v_mov_b32 %0, 0" : "=v"(z_));
    const int wid = wid_, lane = __builtin_amdgcn_mbcnt_hi(~0u, __builtin_amdgcn_mbcnt_lo(~0u, z_)), tid = wid * 64 + lane, wr = wid >> 2, wc = wid & 3, fr = lane & 15, fq = lane >> 4;
    const int K = g.K, nt = K / BK;
    unsigned voffA[2], voffB[2];
#pragma unroll
    for (int i = 0; i < 2; ++i) { int R, C; stage_rc(tid * 16 + i * 8192, R, C); const int Rb = Epi::PERM ? ((R & ~31) + perm32(R & 31)) : R;
        voffA[i] = (unsigned)(R * g.lda + C) * 2u; voffB[i] = (unsigned)(Rb * g.ldb + C) * 2u; }
    const size_t kstep = (size_t)(BK * 2);
    const size_t hA = (size_t)HALF * g.lda * 2, hB = (size_t)HALF * g.ldb * 2;
    const size_t tA = 2 * hA, tB = 2 * hB;
    const unsigned ldsw = (unsigned)wid * 1024u;
    const int aoff = lds_byte(wr * 64 + fr, fq * 8), boff = lds_byte(wc * 32 + fr, fq * 8);
#define PG8_SA(b, h) (((b) * 2 + (h)) * HTB)
#define PG8_SB(b, h) ((4 + (b) * 2 + (h)) * HTB)
#define PG8_STAGE(bufoff, gbase, voff) do { _Pragma("unroll") for (int _i = 0; _i < 2; ++_i) \
        __builtin_amdgcn_global_load_lds((const unsigned*)((const char*)(gbase) + (voff)[_i]), (PG8_LAS unsigned*)(lds + (bufoff) + ldsw + _i * 8192), 16, 0, 0); } while (0)
#define PG8_LDA(dst, b, h) do { _Pragma("unroll") for (int m = 0; m < 4; ++m) _Pragma("unroll") for (int k = 0; k < 2; ++k) dst[m][k] = *(const PG8_LAS bf16x8*)(lds + PG8_SA(b, h) + aoff + m * 2048 + k * 1024); } while (0)
#define PG8_LDB(dst, b, h) do { _Pragma("unroll") for (int n = 0; n < 2; ++n) _Pragma("unroll") for (int k = 0; k < 2; ++k) dst[n][k] = *(const PG8_LAS bf16x8*)(lds + PG8_SB(b, h) + boff + n * 2048 + k * 1024); } while (0)
#define PG8_MMA(ai, bj, At, Bt) do { __builtin_amdgcn_s_setprio(1); _Pragma("unroll") for (int m = 0; m < 4; ++m) _Pragma("unroll") for (int n = 0; n < 2; ++n) _Pragma("unroll") for (int k = 0; k < 2; ++k) \
        acc[ai][bj][m][n] = __builtin_amdgcn_mfma_f32_16x16x32_bf16(Bt[n][k], At[m][k], acc[ai][bj][m][n], 0, 0, 0); __builtin_amdgcn_s_setprio(0); } while (0)
#define PG8_WAIT_V(n) asm volatile("s_waitcnt vmcnt(" #n ")" ::: "memory")
#define PG8_WAIT_L(n) asm volatile("s_waitcnt lgkmcnt(" #n ")" ::: "memory")
#define PG8_BAR __builtin_amdgcn_s_barrier()
#define PG8_SCHED __builtin_amdgcn_sched_barrier(0)
    Unit cur, nxt; int ui = 0;
    if (!S.next(0, cur)) return;
    f32x4 acc[2][2][4][2];
#pragma unroll
    for (int a = 0; a < 2; ++a)
#pragma unroll
        for (int b = 0; b < 2; ++b)
#pragma unroll
            for (int m = 0; m < 4; ++m)
#pragma unroll
                for (int n = 0; n < 2; ++n) acc[a][b][m][n] = (f32x4){0.f, 0.f, 0.f, 0.f};
    bf16x8 At[4][2], B0[2][2], B1[2][2];
    const char* cA = (const char*)g.A + (size_t)cur.pm * tA; const char* cB = (const char*)g.Bt + (size_t)cur.pn * tB;
    if constexpr (SP2) {
        PG8_STAGE(PG8_SB(0, 0), cB, voffB); PG8_STAGE(PG8_SB(0, 1), cB + hB, voffB); PG8_STAGE(PG8_SA(0, 0), cA, voffA); PG8_STAGE(PG8_SA(0, 1), cA + hA, voffA);
        if (wr == 1) PG8_BAR;
        PG8_WAIT_V(2); PG8_BAR;
        PG8_STAGE(PG8_SB(1, 0), cB + kstep, voffB); PG8_STAGE(PG8_SA(1, 0), cA + kstep, voffA); PG8_STAGE(PG8_SB(1, 1), cB + hB + kstep, voffB);
        PG8_WAIT_V(6); PG8_BAR;
    } else {
        PG8_STAGE(PG8_SB(0, 0), cB, voffB); PG8_STAGE(PG8_SA(0, 0), cA, voffA); PG8_STAGE(PG8_SB(0, 1), cB + hB, voffB); PG8_STAGE(PG8_SA(0, 1), cA + hA, voffA);
        if (wr == 1) PG8_BAR;
        PG8_WAIT_V(4); PG8_BAR;
        PG8_STAGE(PG8_SB(1, 0), cB + kstep, voffB); PG8_STAGE(PG8_SA(1, 0), cA + kstep, voffA); PG8_STAGE(PG8_SB(1, 1), cB + hB + kstep, voffB);
        PG8_WAIT_V(6); PG8_BAR;
    }
    for (;;) {
        const bool has_next = S.next(ui + 1, nxt);
        const char* nA = has_next ? (const char*)g.A + (size_t)nxt.pm * tA : cA; const char* nB = has_next ? (const char*)g.Bt + (size_t)nxt.pn * tB : cB;
        for (int t = 0; t < nt; t += 2) {
            const bool last = (t == nt - 2);
            const char* a1 = cA + (size_t)(t + 1) * kstep;
            const char* a2 = last ? nA : cA + (size_t)(t + 2) * kstep; const char* b2 = last ? nB : cB + (size_t)(t + 2) * kstep;
            const char* a3 = a2 + kstep; const char* b3 = b2 + kstep;
            if constexpr (SP2) {
            PG8_LDB(B0, 0, 0); PG8_LDB(B1, 0, 1); PG8_SCHED; PG8_LDA(At, 0, 0); PG8_STAGE(PG8_SA(1, 1), a1 + hA, voffA);
            PG8_WAIT_V(8); PG8_WAIT_L(0); PG8_BAR; PG8_MMA(0, 0, At, B0); PG8_MMA(0, 1, At, B1); PG8_BAR; PG8_SCHED;
            PG8_LDA(At, 0, 1); PG8_STAGE(PG8_SB(0, 0), b2, voffB); PG8_STAGE(PG8_SB(0, 1), b2 + hB, voffB); PG8_STAGE(PG8_SA(0, 0), a2, voffA);
            PG8_WAIT_V(8); PG8_WAIT_L(0); PG8_BAR; PG8_MMA(1, 0, At, B0); PG8_MMA(1, 1, At, B1); PG8_BAR; PG8_SCHED;
            PG8_LDB(B0, 1, 0); PG8_LDB(B1, 1, 1); PG8_SCHED; PG8_LDA(At, 1, 0); PG8_STAGE(PG8_SA(0, 1), a2 + hA, voffA);
            PG8_WAIT_V(8); PG8_WAIT_L(0); PG8_BAR; PG8_MMA(0, 0, At, B0); PG8_MMA(0, 1, At, B1); PG8_BAR; PG8_SCHED;
            PG8_LDA(At, 1, 1); PG8_STAGE(PG8_SB(1, 0), b3, voffB); PG8_STAGE(PG8_SB(1, 1), b3 + hB, voffB); PG8_STAGE(PG8_SA(1, 0), a3, voffA);
            PG8_WAIT_V(8); PG8_WAIT_L(0); PG8_BAR; PG8_MMA(1, 0, At, B0); PG8_MMA(1, 1, At, B1); PG8_BAR; PG8_SCHED;
            } else {
            PG8_LDB(B0, 0, 0); PG8_SCHED; PG8_LDA(At, 0, 0); PG8_STAGE(PG8_SA(1, 1), a1 + hA, voffA);
            PG8_WAIT_L(8); PG8_BAR; PG8_WAIT_L(0); PG8_MMA(0, 0, At, B0); PG8_BAR; PG8_SCHED;
            PG8_LDB(B1, 0, 1); PG8_STAGE(PG8_SB(0, 0), b2, voffB);
            PG8_BAR; PG8_WAIT_L(0); PG8_MMA(0, 1, At, B1); PG8_BAR;
            PG8_LDA(At, 0, 1); PG8_STAGE(PG8_SA(0, 0), a2, voffA);
            PG8_BAR; PG8_WAIT_L(0); PG8_MMA(1, 0, At, B0); PG8_BAR; PG8_SCHED;
            PG8_STAGE(PG8_SB(0, 1), b2 + hB, voffB);
            PG8_WAIT_V(6); PG8_BAR; PG8_MMA(1, 1, At, B1); PG8_BAR;
            PG8_LDB(B0, 1, 0); PG8_SCHED; PG8_LDA(At, 1, 0); PG8_STAGE(PG8_SA(0, 1), a2 + hA, voffA);
            PG8_WAIT_L(8); PG8_BAR; PG8_WAIT_L(0); PG8_MMA(0, 0, At, B0); PG8_BAR; PG8_SCHED;
            PG8_LDB(B1, 1, 1); PG8_STAGE(PG8_SB(1, 0), b3, voffB);
            PG8_BAR; PG8_WAIT_L(0); PG8_MMA(0, 1, At, B1); PG8_BAR;
            PG8_LDA(At, 1, 1); PG8_STAGE(PG8_SA(1, 0), a3, voffA);
            PG8_BAR; PG8_WAIT_L(0); PG8_MMA(1, 0, At, B0); PG8_BAR; PG8_SCHED;
            PG8_STAGE(PG8_SB(1, 1), b3 + hB, voffB);
            PG8_WAIT_V(6); PG8_BAR; PG8_MMA(1, 1, At, B1); PG8_BAR;
            }
        }
        if constexpr (ALIGN_EPI) { if (wr == 0) PG8_BAR; }
        E(acc, cur, wr, wc);
        if (!has_next) break;
#pragma unroll
        for (int a = 0; a < 2; ++a)
#pragma unroll
            for (int b = 0; b < 2; ++b)
#pragma unroll
                for (int m = 0; m < 4; ++m)
#pragma unroll
                    for (int n = 0; n < 2; ++n) acc[a][b][m][n] = (f32x4){0.f, 0.f, 0.f, 0.f};
        cur = nxt; cA = nA; cB = nB; ++ui;
        if constexpr (ALIGN_EPI) { if (wr == 1) PG8_BAR; }
    }
    PG8_WAIT_V(0);
    if constexpr (!ALIGN_EPI) { if (wr == 0) PG8_BAR; }
    PG8_BAR;
#undef PG8_SA
#undef PG8_SB
#undef PG8_STAGE
#undef PG8_LDA
#undef PG8_LDB
#undef PG8_MMA
#undef PG8_WAIT_V
#undef PG8_WAIT_L
#undef PG8_BAR
#undef PG8_SCHED
}
}
#define LAS __attribute__((address_space(3)))
typedef unsigned short bf16;
typedef float f32x4 __attribute__((ext_vector_type(4)));
typedef float f32x2 __attribute__((ext_vector_type(2)));
typedef float f32x16 __attribute__((ext_vector_type(16)));
typedef short bf16x8 __attribute__((ext_vector_type(8)));
typedef short s16x4 __attribute__((ext_vector_type(4)));
typedef unsigned u32x4 __attribute__((ext_vector_type(4)));
typedef unsigned u32x2 __attribute__((ext_vector_type(2)));
using pg8::Unit; using pg8::cvt_pk_bf16;
#define RLX_AGENT __ATOMIC_RELAXED, __HIP_MEMORY_SCOPE_AGENT
#define LDS_WAIT() asm volatile("s_waitcnt lgkmcnt(0)" ::: "memory")
#define VM_WAIT() asm volatile("s_waitcnt vmcnt(0)" ::: "memory")

constexpr int NB = 8, SEQ = 4096, NT = NB * SEQ, DM = 1024, DRNN = 1280, QL = 384, KVL = 256, DIN = 4000, NH = 16, DFF = 2816, NUP = 2 * DFF;
constexpr float EPS = 1e-6f;
constexpr float LOG2E = 1.4426950408889634f;
constexpr float QSCALE = 0.10206207261596575f * 1.4426950408889634f;

constexpr size_t MiB = 1u << 20;
constexpr size_t WS_CTL = 0, CTL_ZERO_BYTES = 1 * MiB;
constexpr size_t CTL_BAR = 16384;
constexpr size_t CTL_MOD = 65536;
constexpr size_t CTL_SSQQ = 262144, CTL_SSQKV = 393216;
constexpr size_t WS_WIN = 1 * MiB, WS_WUQ = 9 * MiB, WS_WUKV = 11 * MiB, WS_WPR = 12 * MiB, WS_WPM = 15 * MiB, WS_WOUT = 17 * MiB, WS_WUP = 19 * MiB, WS_WDN = 30 * MiB;
constexpr size_t WS_COS = 36 * MiB, WS_SIN = 38 * MiB;
constexpr size_t WS_R1 = 40 * MiB;
constexpr size_t WS_R2 = 120 * MiB;
constexpr size_t WS_LAT = 200 * MiB;
constexpr size_t WS_Q = 248 * MiB;
constexpr size_t WS_KN = 344 * MiB, WS_V = 408 * MiB, WS_KR = 472 * MiB, WS_END = 474 * MiB;

__device__ __forceinline__ u32x4 pack8(f32x4 a, f32x4 b) { u32x4 w; w.x = cvt_pk_bf16(a[0], a[1]); w.y = cvt_pk_bf16(a[2], a[3]); w.z = cvt_pk_bf16(b[0], b[1]); w.w = cvt_pk_bf16(b[2], b[3]); return w; }
__device__ __forceinline__ float bflo(unsigned w) { return __uint_as_float(w << 16); }
__device__ __forceinline__ float bfhi(unsigned w) { return __uint_as_float(w & 0xffff0000u); }
__device__ __forceinline__ float fsigmoid(float v) { return __builtin_amdgcn_rcpf(1.f + __builtin_amdgcn_exp2f(-LOG2E * v)); }
__device__ __forceinline__ float sumsq4(f32x4 v) { return (v[0] * v[0] + v[1] * v[1]) + (v[2] * v[2] + v[3] * v[3]); }
__device__ __forceinline__ float wave_sum(float v) {
#pragma unroll
    for (int o = 1; o < 64; o <<= 1) v += __shfl_xor(v, o);
    return v;
}

#define XB_TMO      128
#define XB_XCNT(j)  (256  + 64 * (j))
#define XB_XSUB(j)  (1280 + 64 * (j))
#define XB_XGEN(j)  (2304 + 64 * (j))
#define XB_TOP      3328
#define XB_TOPGEN   3392
#define XCD_BAR_WORDS 3456
#define XB_SPIN_CAP (1u << 18)
__device__ __forceinline__ unsigned xb_ld(unsigned* p)              { return __hip_atomic_load(p, __ATOMIC_RELAXED, __HIP_MEMORY_SCOPE_AGENT); }
__device__ __forceinline__ unsigned xb_add(unsigned* p, unsigned v) { return __hip_atomic_fetch_add(p, v, __ATOMIC_RELAXED, __HIP_MEMORY_SCOPE_AGENT); }
__device__ __forceinline__ unsigned xb_xcc_id() { return (unsigned)__builtin_amdgcn_s_getreg((3 << 11) | 20) & 0xFu; }
#define XB_SPIN(cond, bar) do { unsigned _sp = 0; while (cond) { __builtin_amdgcn_s_sleep(1); \
    if ((++_sp & 255u) == 0u) { if (xb_ld(&(bar)[XB_TMO])) break; if (_sp > XB_SPIN_CAP) { atomicAdd(&(bar)[XB_TMO], 1u); break; } } } } while (0)
struct XcdBarrier { unsigned* bar; unsigned x; volatile LAS unsigned* st; };
__device__ __forceinline__ XcdBarrier xcd_barrier_post(unsigned* bar, volatile LAS unsigned* st) {
    XcdBarrier b; b.bar = bar; b.x = xb_xcc_id(); b.st = st;
    if (threadIdx.x == 0) (void)xb_add(&bar[XB_XCNT(b.x)], 1u);
    return b;
}
__device__ __forceinline__ void xcd_barrier_complete(unsigned* bar, unsigned x, unsigned& nloc, unsigned& nx) {
    const unsigned G = gridDim.x * gridDim.y * gridDim.z;
    unsigned sum, cnt, mine, sp = 0u;
    for (;;) {
        sum = 0u; cnt = 0u; mine = 0u;
#pragma unroll
        for (unsigned j = 0; j < 16; ++j) { const unsigned c = xb_ld(&bar[XB_XCNT(j)]); sum += c; cnt += (c > 0u) ? 1u : 0u; mine = (j == x) ? c : mine; }
        if (sum == G) break;
        __builtin_amdgcn_s_sleep(1);
        if ((++sp & 255u) == 0u) { if (xb_ld(&bar[XB_TMO])) break; if (sp > XB_SPIN_CAP) { atomicAdd(&bar[XB_TMO], 1u); break; } }
    }
    nloc = mine > 0u ? mine : 1u; nx = cnt > 0u ? cnt : 1u;
}
__device__ __forceinline__ void xcd_barrier(const XcdBarrier& b) {
    asm volatile("s_waitcnt vmcnt(0)" ::: "memory");
    __syncthreads();
    if (threadIdx.x == 0) {
        unsigned* bar = b.bar;
        __builtin_amdgcn_s_waitcnt(0);
        unsigned nloc = b.st[0], nx = b.st[1];
        if (nloc == 0u) { xcd_barrier_complete(bar, b.x, nloc, nx); b.st[0] = nloc; b.st[1] = nx; }
        const unsigned old = xb_add(&bar[XB_XSUB(b.x)], 1u);
        const unsigned gen = old / nloc;
        if (old + 1u == (gen + 1u) * nloc) {
            __builtin_amdgcn_fence(__ATOMIC_RELEASE, "agent");
            asm volatile("s_waitcnt vmcnt(0)" ::: "memory");
            const unsigned og = xb_add(&bar[XB_TOP], 1u);
            const unsigned tg = og / nx;
            if (og + 1u == (tg + 1u) * nx) xb_add(&bar[XB_TOPGEN], 1u);
            else XB_SPIN(xb_ld(&bar[XB_TOPGEN]) == tg, bar);
            __builtin_amdgcn_fence(__ATOMIC_ACQUIRE, "agent");
            xb_add(&bar[XB_XGEN(b.x)], 1u);
            asm volatile("s_waitcnt vmcnt(0)" ::: "memory");
        } else {
            XB_SPIN(xb_ld(&bar[XB_XGEN(b.x)]) == gen, bar);
            __builtin_amdgcn_fence(__ATOMIC_ACQUIRE, "agent");
            asm volatile("s_waitcnt vmcnt(0)" ::: "memory");
        }
    }
    __syncthreads();
}
__device__ __forceinline__ void rope8(f32x4& v0, f32x4& v1, const float* cosT, const float* sinT, int row, int fq) {
    const float* cp = cosT + (size_t)row * 16 + 4 * fq; const float* sp = sinT + (size_t)row * 16 + 4 * fq;
    { const f32x2 c = *(const f32x2*)cp, s = *(const f32x2*)sp; const float x0 = v0[0], x1 = v0[1], x2 = v0[2], x3 = v0[3];
      v0[0] = x0 * c[0] - x1 * s[0]; v0[1] = x1 * c[0] + x0 * s[0]; v0[2] = x2 * c[1] - x3 * s[1]; v0[3] = x3 * c[1] + x2 * s[1]; }
    asm volatile("" : "+v"(v0));
    { const f32x2 c = *(const f32x2*)(cp + 2), s = *(const f32x2*)(sp + 2); const float x0 = v1[0], x1 = v1[1], x2 = v1[2], x3 = v1[3];
      v1[0] = x0 * c[0] - x1 * s[0]; v1[1] = x1 * c[0] + x0 * s[0]; v1[2] = x2 * c[1] - x3 * s[1]; v1[3] = x3 * c[1] + x2 * s[1]; }
}
struct EpiIn {
    static constexpr bool PERM = true;
    bf16 *XR, *LAT, *KR, *SG; float *ssq_q, *ssq_kv; const float *cosT, *sinT;
    __device__ __forceinline__ void operator()(f32x4 (&acc)[2][2][4][2], const Unit& u, int wr, int wc) const {
        int z_; asm volatile("v_mov_b32 %0, 0" : "=v"(z_)); const int lane_ = __builtin_amdgcn_mbcnt_hi(~0u, __builtin_amdgcn_mbcnt_lo(~0u, z_)), fr = lane_ & 15, fq = lane_ >> 4;
        const int row0 = u.pm * 256 + wr * 64 + fr, pn = u.pn, cw = wc * 32 + 8 * fq;
        if (pn < 5) {
#pragma unroll
            for (int ai = 0; ai < 2; ++ai)
#pragma unroll
                for (int m = 0; m < 4; ++m) { bf16* rowp = XR + (size_t)(row0 + ai * 128 + m * 16) * DRNN + pn * 256 + cw;
#pragma unroll
                    for (int bj = 0; bj < 2; ++bj) *(u32x4*)(rowp + bj * 128) = pack8(acc[ai][bj][m][0], acc[ai][bj][m][1]); }
        } else if (pn < 8) {
            const int ct = (pn - 5) * 256;
#pragma unroll
            for (int ai = 0; ai < 2; ++ai)
#pragma unroll
                for (int m = 0; m < 4; ++m) { const int row = row0 + ai * 128 + m * 16; bf16* rowp = LAT + (size_t)row * 768 + ct + cw;
                    float s0 = sumsq4(acc[ai][0][m][0]) + sumsq4(acc[ai][0][m][1]), s1 = sumsq4(acc[ai][1][m][0]) + sumsq4(acc[ai][1][m][1]);
                    *(u32x4*)(rowp) = pack8(acc[ai][0][m][0], acc[ai][0][m][1]);
                    if (pn != 7) *(u32x4*)(rowp + 128) = pack8(acc[ai][1][m][0], acc[ai][1][m][1]);
                    else if (wc == 0) { f32x4 v0 = acc[ai][1][m][0], v1 = acc[ai][1][m][1]; rope8(v0, v1, cosT, sinT, row, fq); *(u32x4*)(KR + (size_t)row * 32 + 8 * fq) = pack8(v0, v1); }
                    if (pn == 5) { s0 += s1; s1 = 0.f; }
                    s0 += __shfl_xor(s0, 16); s0 += __shfl_xor(s0, 32); s1 += __shfl_xor(s1, 16); s1 += __shfl_xor(s1, 32);
                    if (fq == 0) { if (pn == 7) unsafeAtomicAdd(ssq_kv + row, s0); else { unsafeAtomicAdd(ssq_q + row, s0); if (pn == 6) unsafeAtomicAdd(ssq_kv + row, s1); } } }
        } else {
            const int ct = (pn - 8) * 256;
#pragma unroll
            for (int ai = 0; ai < 2; ++ai)
#pragma unroll
                for (int m = 0; m < 4; ++m) { bf16* rowp = SG + (size_t)(row0 + ai * 128 + m * 16) * 2048 + ct + cw;
#pragma unroll
                    for (int bj = 0; bj < 2; ++bj) { f32x4 a = acc[ai][bj][m][0], b = acc[ai][bj][m][1];
#pragma unroll
                        for (int e = 0; e < 4; ++e) { a[e] = fsigmoid(a[e]); b[e] = fsigmoid(b[e]); }
                        *(u32x4*)(rowp + bj * 128) = pack8(a, b); } }
        }
    }
};
struct EpiQ {
    static constexpr bool PERM = true;
    bf16* Q; const float* ssq; const float *cosT, *sinT;
    __device__ __forceinline__ void operator()(f32x4 (&acc)[2][2][4][2], const Unit& u, int wr, int wc) const {
        int z_; asm volatile("v_mov_b32 %0, 0" : "=v"(z_)); const int lane_ = __builtin_amdgcn_mbcnt_hi(~0u, __builtin_amdgcn_mbcnt_lo(~0u, z_)), fr = lane_ & 15, fq = lane_ >> 4;
        const int row0 = u.pm * 256 + wr * 64 + fr, pn = u.pn, cw = wc * 32 + 8 * fq;
#pragma unroll
        for (int ai = 0; ai < 2; ++ai)
#pragma unroll
            for (int m = 0; m < 4; ++m) { const int row = row0 + ai * 128 + m * 16; const float rs = rsqrtf(ssq[row] * (1.f / QL) + EPS) * QSCALE; bf16* rowp = Q + (size_t)row * 1536 + pn * 256 + cw;
#pragma unroll
                for (int bj = 0; bj < 2; ++bj) { f32x4 v0 = acc[ai][bj][m][0] * rs, v1 = acc[ai][bj][m][1] * rs;
                    if ((8 * pn + 4 * bj + wc) % 3 == 2) rope8(v0, v1, cosT, sinT, row, fq);
                    *(u32x4*)(rowp + bj * 128) = pack8(v0, v1); }
                asm volatile("" ::: "memory"); }
    }
};
struct EpiKV {
    static constexpr bool PERM = true;
    bf16 *KN, *V; const float* ssq;
    __device__ __forceinline__ void operator()(f32x4 (&acc)[2][2][4][2], const Unit& u, int wr, int wc) const {
        int z_; asm volatile("v_mov_b32 %0, 0" : "=v"(z_)); const int lane_ = __builtin_amdgcn_mbcnt_hi(~0u, __builtin_amdgcn_mbcnt_lo(~0u, z_)), fr = lane_ & 15, fq = lane_ >> 4;
        const int row0 = u.pm * 256 + wr * 64 + fr, pn = u.pn, cw = wc * 32 + 8 * fq; bf16* base = (pn < 4) ? KN : V; const int ct = (pn & 3) * 256;
#pragma unroll
        for (int ai = 0; ai < 2; ++ai)
#pragma unroll
            for (int m = 0; m < 4; ++m) { const int row = row0 + ai * 128 + m * 16; const float rs = rsqrtf(ssq[row] * (1.f / KVL) + EPS); bf16* rowp = base + (size_t)row * 1024 + ct + cw;
#pragma unroll
                for (int bj = 0; bj < 2; ++bj) *(u32x4*)(rowp + bj * 128) = pack8(acc[ai][bj][m][0] * rs, acc[ai][bj][m][1] * rs);
                asm volatile("" ::: "memory"); }
    }
};
template <bool SECOND> struct EpiMerge {
    static constexpr bool PERM = true;
    bf16* MG; const bf16* SG; int sgoff;
    __device__ __forceinline__ void operator()(f32x4 (&acc)[2][2][4][2], const Unit& u, int wr, int wc) const {
        int z_; asm volatile("v_mov_b32 %0, 0" : "=v"(z_)); const int lane_ = __builtin_amdgcn_mbcnt_hi(~0u, __builtin_amdgcn_mbcnt_lo(~0u, z_)), fr = lane_ & 15, fq = lane_ >> 4;
        const int row0 = u.pm * 256 + wr * 64 + fr, col0 = u.pn * 256 + wc * 32 + 8 * fq;
#pragma unroll
        for (int ai = 0; ai < 2; ++ai)
#pragma unroll
            for (int m = 0; m < 4; ++m) { const int row = row0 + ai * 128 + m * 16; bf16* rowp = MG + (size_t)row * 1024 + col0; const bf16* sgp = SG + (size_t)row * 2048 + sgoff + col0;
#pragma unroll
                for (int bj = 0; bj < 2; ++bj) { const u32x4 g = *(const u32x4*)(sgp + bj * 128); f32x4 v0 = acc[ai][bj][m][0], v1 = acc[ai][bj][m][1];
                    v0[0] *= bflo(g.x); v0[1] *= bfhi(g.x); v0[2] *= bflo(g.y); v0[3] *= bfhi(g.y); v1[0] *= bflo(g.z); v1[1] *= bfhi(g.z); v1[2] *= bflo(g.w); v1[3] *= bfhi(g.w);
                    if (SECOND) { const u32x4 p = *(const u32x4*)(rowp + bj * 128);
                        v0[0] += bflo(p.x); v0[1] += bfhi(p.x); v0[2] += bflo(p.y); v0[3] += bfhi(p.y); v1[0] += bflo(p.z); v1[1] += bfhi(p.z); v1[2] += bflo(p.w); v1[3] += bfhi(p.w); }
                    *(u32x4*)(rowp + bj * 128) = pack8(v0, v1); } }
    }
};
struct EpiRes {
    static constexpr bool PERM = false;
    const float* base; float* out; const float* mod; int goff;
    __device__ __forceinline__ void operator()(f32x4 (&acc)[2][2][4][2], const Unit& u, int wr, int wc) const {
        int z_; asm volatile("v_mov_b32 %0, 0" : "=v"(z_)); const int lane_ = __builtin_amdgcn_mbcnt_hi(~0u, __builtin_amdgcn_mbcnt_lo(~0u, z_)), fr = lane_ & 15, fq = lane_ >> 4;
        const int row0 = u.pm * 256 + wr * 64 + fr, col0 = u.pn * 256 + wc * 32 + 4 * fq; const float* gate = mod + (u.pm >> 4) * 6144 + goff;
#pragma unroll
        for (int bj = 0; bj < 2; ++bj)
#pragma unroll
            for (int n = 0; n < 2; ++n) { const int col = col0 + bj * 128 + n * 16; const f32x4 gv = *(const f32x4*)(gate + col);
#pragma unroll
                for (int ai = 0; ai < 2; ++ai)
#pragma unroll
                    for (int m = 0; m < 4; ++m) { const size_t off = (size_t)(row0 + ai * 128 + m * 16) * 1024 + col; *(f32x4*)(out + off) = *(const f32x4*)(base + off) + gv * acc[ai][bj][m][n]; } }
    }
};
template <int CTRL> __device__ __forceinline__ float dpp_mov(float old, float src) { return __builtin_bit_cast(float, __builtin_amdgcn_update_dpp(__builtin_bit_cast(int, old), __builtin_bit_cast(int, src), CTRL, 0xf, 0xf, false)); }
struct EpiUp {
    static constexpr bool PERM = true;
    bf16* ACT; float* SIDE; const float *cw, *cb;
    __device__ __forceinline__ void operator()(f32x4 (&acc)[2][2][4][2], const Unit& u, int wr, int wc) const {
        int z_; asm volatile("v_mov_b32 %0, 0" : "=v"(z_)); const int lane_ = __builtin_amdgcn_mbcnt_hi(~0u, __builtin_amdgcn_mbcnt_lo(~0u, z_)), fr = lane_ & 15, fq = lane_ >> 4;
        const int row0 = u.pm * 256 + wr * 64 + fr, pn = u.pn, cwo = wc * 32 + 8 * fq;
        if (fr < 2 || fr >= 14) {
#pragma unroll
            for (int ai = 0; ai < 2; ++ai) { const int grp = (u.pm * 256 + ai * 128 + wr * 64) >> 6; const int m = (fr < 2) ? 0 : 3; const int slot = (fr < 2) ? fr : fr - 12;
                float* sp = SIDE + ((size_t)grp * 4 + slot) * NUP + pn * 256 + cwo;
#pragma unroll
                for (int bj = 0; bj < 2; ++bj)
#pragma unroll
                    for (int n = 0; n < 2; ++n) { const f32x4 v = (m == 0) ? acc[ai][bj][0][n] : acc[ai][bj][3][n]; *(f32x4*)(sp + bj * 128 + 4 * n) = v; } }
        }
#pragma unroll
        for (int n = 0; n < 2; ++n) {
            const int f0 = pn * 128 + cwo + 4 * n;
            f32x4 wg[3], wv[3];
#pragma unroll
            for (int k = 0; k < 3; ++k) { wg[k] = *(const f32x4*)(cw + k * NUP + f0); wv[k] = *(const f32x4*)(cw + k * NUP + DFF + f0); }
            const f32x4 bg = *(const f32x4*)(cb + f0), bv = *(const f32x4*)(cb + DFF + f0);
#pragma unroll
            for (int ai = 0; ai < 2; ++ai) {
                f32x4 pg = (f32x4){0.f, 0.f, 0.f, 0.f}, pv = pg;
#pragma unroll
                for (int m = 0; m < 4; ++m) { const f32x4 g = acc[ai][0][m][n], v = acc[ai][1][m][n]; f32x4 ug, uv;
#pragma unroll
                    for (int e = 0; e < 4; ++e) {
                        const float g1 = dpp_mov<0x111>(dpp_mov<0x121>(0.f, pg[e]), g[e]), g2 = dpp_mov<0x112>(dpp_mov<0x122>(0.f, pg[e]), g[e]);
                        const float v1 = dpp_mov<0x111>(dpp_mov<0x121>(0.f, pv[e]), v[e]), v2 = dpp_mov<0x112>(dpp_mov<0x122>(0.f, pv[e]), v[e]);
                        ug[e] = bg[e] + wg[2][e] * g[e] + wg[1][e] * g1 + wg[0][e] * g2; uv[e] = bv[e] + wv[2][e] * v[e] + wv[1][e] * v1 + wv[0][e] * v2; }
                    f32x4 o;
#pragma unroll
                    for (int e = 0; e < 4; ++e) o[e] = ug[e] * fsigmoid(ug[e]) * uv[e];
                    u32x2 w; w.x = cvt_pk_bf16(o[0], o[1]); w.y = cvt_pk_bf16(o[2], o[3]);
                    *(u32x2*)(ACT + (size_t)(row0 + ai * 128 + m * 16) * DFF + f0) = w;
                    pg = g; pv = v; }
            }
        }
    }
};
constexpr int NWAVES = 8;
constexpr int RING_OFF = 0, RING_BYTES = 131072;
constexpr int LDSCTL_OFF = RING_BYTES, MISC_OFF = LDSCTL_OFF + 320;
constexpr int LDS_BYTES = 147456;
struct Args { const float* in[27]; float* out; unsigned char* ws; int ph_lo, ph_hi; };
typedef const __attribute__((address_space(4))) Args* KArgs;
struct Frame {
    LAS unsigned char* lds; volatile LAS unsigned* MISC; unsigned char* ws; KArgs ka;
    int wave, vcu, G;
    float* out;
};
#define INP(i) (F.ka->in[i])
__device__ __forceinline__ int lane_id() { int z; asm volatile("v_mov_b32 %0, 0" : "=v"(z)); return __builtin_amdgcn_mbcnt_hi(~0u, __builtin_amdgcn_mbcnt_lo(~0u, z)); }

__device__ __forceinline__ void p0_transpose_item(const float* W, int K, int N, bf16* WT, int kb, int dst_row0, int src0, bool ilv, const float* kscale, LAS float* scr, int lane) {
    const int k0 = 64 * kb; const int sc = lane & 31; const int dn = ilv ? (2 * (sc & 15) + (sc >> 4)) : sc;
#pragma unroll 8
    for (int i = 0; i < 32; ++i) { const int kk = 2 * i + (lane >> 5); float v = W[(size_t)(k0 + kk) * N + src0 + sc]; if (kscale) v *= kscale[k0 + kk]; scr[kk * 33 + dn] = v; }
    LDS_WAIT(); asm volatile("" ::: "memory");
    const int c = lane & 7;
#pragma unroll
    for (int j = 0; j < 4; ++j) { const int n = (lane >> 3) + 8 * j; const LAS float* s = scr + (8 * c) * 33 + n;
        u32x4 o; o.x = cvt_pk_bf16(s[0 * 33], s[1 * 33]); o.y = cvt_pk_bf16(s[2 * 33], s[3 * 33]); o.z = cvt_pk_bf16(s[4 * 33], s[5 * 33]); o.w = cvt_pk_bf16(s[6 * 33], s[7 * 33]);
        *(u32x4*)(WT + (size_t)(dst_row0 + n) * K + k0 + 8 * c) = o; }
    LDS_WAIT(); asm volatile("" ::: "memory");
}
__device__ __forceinline__ void p0_prologue(Frame& F) {
    LAS float* scr = (LAS float*)(F.lds + RING_OFF + F.wave * 16384); const int lane = lane_id();
    const int gw = F.vcu * NWAVES + F.wave, NGW = F.G * NWAVES;
    constexpr int I_IN = 16 * 128, I_UQ = 6 * 48, I_UKV = 4 * 64, I_PR = 20 * 32, I_PM = 16 * 32, I_OUT = 16 * 32, I_UP = 16 * 176, I_DN = 44 * 32;
    constexpr int NITEMS = I_IN + I_UQ + I_UKV + I_PR + I_PM + I_OUT + I_UP + I_DN;
    for (int it = gw; it < NITEMS; it += NGW) {
        int r = it;
        if (r < I_IN) { const int nb = r % 128, kb = r / 128; if (nb >= 61 && nb < 64) continue; const int src0 = nb < 61 ? 32 * nb : 1952 + 32 * (nb - 64);
            p0_transpose_item(INP(6), DM, DIN, (bf16*)(F.ws + WS_WIN), kb, 32 * nb, src0, nb == 60, nullptr, scr, lane); continue; } r -= I_IN;
        if (r < I_UQ) { const int nb = r % 48, kb = r / 48; p0_transpose_item(INP(15), QL, 1536, (bf16*)(F.ws + WS_WUQ), kb, 32 * nb, 32 * nb, (nb % 3) == 2, INP(14), scr, lane); continue; } r -= I_UQ;
        if (r < I_UKV) { const int nb = r % 64, kb = r / 64; const int nb2 = nb & 31, hh = nb2 >> 1, half = nb2 & 1; const int src0 = 128 * hh + (nb >= 32 ? 64 : 0) + 32 * half;
            p0_transpose_item(INP(17), KVL, 2048, (bf16*)(F.ws + WS_WUKV), kb, 32 * nb, src0, false, INP(16), scr, lane); continue; } r -= I_UKV;
        if (r < I_PR) { const int nb = r % 32, kb = r / 32; p0_transpose_item(INP(18), DRNN, DM, (bf16*)(F.ws + WS_WPR), kb, 32 * nb, 32 * nb, false, nullptr, scr, lane); continue; } r -= I_PR;
        if (r < I_PM) { const int nb = r % 32, kb = r / 32; p0_transpose_item(INP(19), DM, DM, (bf16*)(F.ws + WS_WPM), kb, 32 * nb, 32 * nb, false, nullptr, scr, lane); continue; } r -= I_PM;
        if (r < I_OUT) { const int nb = r % 32, kb = r / 32; p0_transpose_item(INP(20), DM, DM, (bf16*)(F.ws + WS_WOUT), kb, 32 * nb, 32 * nb, false, nullptr, scr, lane); continue; } r -= I_OUT;
        if (r < I_UP) { const int nb = r % 176, kb = r / 176; const int j = nb >> 3, w = nb & 7; const int src0 = (w < 4) ? 128 * j + 32 * w : DFF + 128 * j + 32 * (w - 4);
            p0_transpose_item(INP(22), DM, NUP, (bf16*)(F.ws + WS_WUP), kb, 32 * nb, src0, false, nullptr, scr, lane); continue; } r -= I_UP;
        { const int nb = r % 32, kb = r / 32; p0_transpose_item(INP(25), DFF, DM, (bf16*)(F.ws + WS_WDN), kb, 32 * nb, 32 * nb, false, nullptr, scr, lane); }
    }
    float* mod = (float*)(F.ws + WS_CTL + CTL_MOD);
    for (int it = gw; it < 96 * 16; it += NGW) { const int cc = it % 96, ks = it / 96, col = cc * 64 + lane, k0 = ks * 64;
#pragma unroll
        for (int b = 0; b < 8; ++b) { const float cv = INP(1)[b * DM + k0 + lane]; scr[b * 64 + lane] = cv * fsigmoid(cv); }
        LDS_WAIT(); asm volatile("" ::: "memory");
        float a[8];
#pragma unroll
        for (int b = 0; b < 8; ++b) a[b] = (ks == 0) ? INP(4)[col] : 0.f;
#pragma unroll 8
        for (int k = 0; k < 64; ++k) { const float w = INP(3)[(size_t)(k0 + k) * 6144 + col];
#pragma unroll
            for (int b = 0; b < 8; ++b) a[b] += scr[b * 64 + k] * w; }
#pragma unroll
        for (int b = 0; b < 8; ++b) unsafeAtomicAdd(mod + b * 6144 + col, a[b]);
        LDS_WAIT(); asm volatile("" ::: "memory");
    }
    float* cosT = (float*)(F.ws + WS_COS); float* sinT = (float*)(F.ws + WS_SIN); const int* pos = (const int*)INP(2);
    for (int i = F.vcu * 512 + F.wave * 64 + lane; i < NT * 16; i += F.G * 512) { const int t = i >> 4, j = i & 15;
        const float inv = powf(10000.f, -(float)j / 16.f); const float ang = (float)pos[t] * inv;
        cosT[i] = cosf(ang); sinT[i] = sinf(ang); }
}

__device__ __forceinline__ void norm_rows_mod(Frame& F, const float* src, bf16* dst, const float* g, int soff, int hoff) {
    const int lane = lane_id(); const int gw = F.vcu * NWAVES + F.wave, NGW = F.G * NWAVES; const float* mod = (const float*)(F.ws + WS_CTL + CTL_MOD);
    for (int rb = gw; rb < NT / 16; rb += NGW) { const int b = rb >> 8; const float* mb = mod + b * 6144;
        f32x4 gg[4], sh[4];
#pragma unroll
        for (int j = 0; j < 4; ++j) { const int col = 4 * lane + 256 * j; const f32x4 gv = *(const f32x4*)(g + col), sc = *(const f32x4*)(mb + soff + col); gg[j] = gv * (sc + 1.0f); sh[j] = *(const f32x4*)(mb + hoff + col); }
        for (int r = 0; r < 16; ++r) { const size_t row = (size_t)rb * 16 + r; const f32x4* xr = (const f32x4*)(src + row * DM) + lane;
            f32x4 v[4]; float s = 0.f;
#pragma unroll
            for (int j = 0; j < 4; ++j) { v[j] = xr[64 * j]; s += sumsq4(v[j]); }
            const float rinv = rsqrtf(wave_sum(s) * (1.f / DM) + EPS);
            u32x2* o8 = (u32x2*)(dst + row * DM) + lane;
#pragma unroll
            for (int j = 0; j < 4; ++j) { const f32x4 y = v[j] * rinv * gg[j] + sh[j]; u32x2 w; w.x = cvt_pk_bf16(y[0], y[1]); w.y = cvt_pk_bf16(y[2], y[3]); o8[64 * j] = w; } }
    }
}
__device__ __forceinline__ void norm_rows_final(Frame& F, float* io, const float* g) {
    const int lane = lane_id(); const int gw = F.vcu * NWAVES + F.wave, NGW = F.G * NWAVES;
    f32x4 gg[4];
#pragma unroll
    for (int j = 0; j < 4; ++j) gg[j] = *(const f32x4*)(g + 4 * lane + 256 * j);
    for (int row = gw; row < NT; row += NGW) { f32x4* xr = (f32x4*)(io + (size_t)row * DM) + lane;
        f32x4 v[4]; float s = 0.f;
#pragma unroll
        for (int j = 0; j < 4; ++j) { v[j] = xr[64 * j]; s += sumsq4(v[j]); }
        const float rinv = rsqrtf(wave_sum(s) * (1.f / DM) + EPS);
#pragma unroll
        for (int j = 0; j < 4; ++j) xr[64 * j] = v[j] * rinv * gg[j]; }
}
__device__ __forceinline__ void ffn_fixup(Frame& F, bf16* ACT, const float* SIDE, const float* cw, const float* cb) {
    const int lane = lane_id(); const int gw = F.vcu * NWAVES + F.wave, NGW = F.G * NWAVES;
    for (int it = gw; it < 512 * 22; it += NGW) { const int grp = it / 22, j = it % 22, rs = lane >> 5, l = lane & 31, f0 = 128 * j + 4 * l;
        const float* s0 = SIDE + ((size_t)grp * 4) * NUP + 256 * j + 4 * l; const float* sp = s0 - (size_t)4 * NUP;
        const bool first = (grp & 63) == 0;
        const f32x4 z = (f32x4){0.f, 0.f, 0.f, 0.f};
        f32x4 cur[2], p1[2], p2[2];
#pragma unroll
        for (int h = 0; h < 2; ++h) { const int co = 128 * h;
            const f32x4 r0 = *(const f32x4*)(s0 + co), r1 = *(const f32x4*)(s0 + NUP + co);
            const f32x4 q63 = first ? z : *(const f32x4*)(sp + 3 * (size_t)NUP + co), q62 = first ? z : *(const f32x4*)(sp + 2 * (size_t)NUP + co);
            cur[h] = rs ? r1 : r0; p1[h] = rs ? r0 : q63; p2[h] = rs ? q63 : q62; }
        f32x4 u[2];
#pragma unroll
        for (int h = 0; h < 2; ++h) { const int fo = h * DFF + f0; u[h] = *(const f32x4*)(cb + fo) + *(const f32x4*)(cw + 2 * NUP + fo) * cur[h] + *(const f32x4*)(cw + NUP + fo) * p1[h] + *(const f32x4*)(cw + fo) * p2[h]; }
        f32x4 o;
#pragma unroll
        for (int e = 0; e < 4; ++e) o[e] = u[0][e] * fsigmoid(u[0][e]) * u[1][e];
        u32x2 w; w.x = cvt_pk_bf16(o[0], o[1]); w.y = cvt_pk_bf16(o[2], o[3]);
        *(u32x2*)(ACT + ((size_t)grp * 64 + rs) * DFF + f0) = w; }
}
__device__ __forceinline__ int crow(int r, int hi) { return (r & 3) + 8 * (r >> 2) + 4 * hi; }
namespace rnn {
constexpr int L_WG = 0, L_CW = 18432, L_CB = L_CW + 1024, L_TOT = L_CB + 256, L_END = L_TOT + 8192;
__device__ __forceinline__ void unit(Frame& F, int b, int n) {
    LAS unsigned char* L = F.lds; const int lane = lane_id(), wid = F.wave, tid = wid * 64 + lane, r32 = lane & 31, hi = lane >> 5;
    const bf16* XR = (const bf16*)(F.ws + WS_R2); bf16* YR = (bf16*)(F.ws + WS_R1); const int* pos = (const int*)INP(2) + b * SEQ;
    __syncthreads();
    { const float* wa = INP(9) + n * 4096; const float* wx = INP(11) + n * 4096; LAS bf16* wg = (LAS bf16*)(L + L_WG);
      for (int i = tid; i < 4096; i += 512) { const int d = i >> 6, e = i & 63; wg[e * 72 + d] = (bf16)(cvt_pk_bf16(wa[i], 0.f) & 0xffffu); wg[(64 + e) * 72 + d] = (bf16)(cvt_pk_bf16(wx[i], 0.f) & 0xffffu); }
      if (tid < 256) ((LAS float*)(L + L_CW))[tid] = INP(7)[(tid >> 6) * DRNN + 64 * n + (tid & 63)];
      if (tid < 64) ((LAS float*)(L + L_CB))[tid] = INP(8)[64 * n + tid]; }
    __syncthreads();
    const LAS unsigned char* wgL = L + L_WG + (r32 * 72 + 8 * hi) * 2;
    float cba[2], cbx[2], ckc[2], carry[2];
#pragma unroll
    for (int nt = 0; nt < 2; ++nt) { const int ch = 64 * n + 32 * nt + r32; cba[nt] = INP(10)[ch]; cbx[nt] = INP(12)[ch]; const float Lp = INP(13)[ch]; ckc[nt] = -8.f * ((-Lp > 20.f) ? -Lp : log1pf(expf(-Lp))); carry[nt] = 0.f; }
    const LAS float* cwL = (const LAS float*)(L + L_CW); const LAS float* cbL = (const LAS float*)(L + L_CB);
    for (int chunk = 0; chunk < 16; ++chunk) {
        const int tok0 = chunk * 256 + wid * 32, tA = tok0 + r32;
        const unsigned long long rmask = __ballot(pos[tA] == 0);
        bf16x8 A[4];
#pragma unroll
        for (int kk = 0; kk < 4; ++kk) { const int c0 = 16 * kk + 8 * hi;
            f32x4 a0 = *(const LAS f32x4*)(cbL + c0), a1 = *(const LAS f32x4*)(cbL + c0 + 4);
#pragma unroll
            for (int tap = 0; tap < 4; ++tap) { const int tt = tA - 3 + tap; const int ttc = tt < 0 ? 0 : tt;
                u32x4 xv = *(const u32x4*)(XR + (size_t)(b * SEQ + ttc) * DRNN + 64 * n + c0); if (tt < 0) xv = (u32x4){0u, 0u, 0u, 0u};
                const f32x4 w0 = *(const LAS f32x4*)(cwL + tap * 64 + c0), w1 = *(const LAS f32x4*)(cwL + tap * 64 + c0 + 4);
                a0[0] += w0[0] * bflo(xv.x); a0[1] += w0[1] * bfhi(xv.x); a0[2] += w0[2] * bflo(xv.y); a0[3] += w0[3] * bfhi(xv.y);
                a1[0] += w1[0] * bflo(xv.z); a1[1] += w1[1] * bfhi(xv.z); a1[2] += w1[2] * bflo(xv.w); a1[3] += w1[3] * bfhi(xv.w); }
            A[kk] = __builtin_bit_cast(bf16x8, pack8(a0, a1)); }
        LAS float* tot = (LAS float*)(L + L_TOT) + (chunk & 1) * 1024;
        float aa[2][16], bb[2][16], As[2][8], Bs[2][8];
#pragma unroll
        for (int nt = 0; nt < 2; ++nt) {
            f32x16 za = {}, zx = {}, xc = {};
#pragma unroll
            for (int kk = 0; kk < 4; ++kk) {
                const int dd = 32 * nt + r32 - 16 * kk - 8 * hi; u32x4 iw;
                iw.x = dd == 0 ? 0x3F80u : dd == 1 ? 0x3F800000u : 0u; iw.y = dd == 2 ? 0x3F80u : dd == 3 ? 0x3F800000u : 0u; iw.z = dd == 4 ? 0x3F80u : dd == 5 ? 0x3F800000u : 0u; iw.w = dd == 6 ? 0x3F80u : dd == 7 ? 0x3F800000u : 0u;
                const bf16x8 fa = *(const LAS bf16x8*)(wgL + (32 * nt * 72 + 16 * kk) * 2), fx = *(const LAS bf16x8*)(wgL + ((64 + 32 * nt) * 72 + 16 * kk) * 2);
                za = __builtin_amdgcn_mfma_f32_32x32x16_bf16(A[kk], fa, za, 0, 0, 0);
                zx = __builtin_amdgcn_mfma_f32_32x32x16_bf16(A[kk], fx, zx, 0, 0, 0);
                xc = __builtin_amdgcn_mfma_f32_32x32x16_bf16(A[kk], __builtin_bit_cast(bf16x8, iw), xc, 0, 0, 0); }
#pragma unroll
            for (int r = 0; r < 16; ++r) {
                const float rg = fsigmoid(za[r] + cba[nt]), ig = fsigmoid(zx[r] + cbx[nt]); const float la = ckc[nt] * rg; float a = __builtin_amdgcn_exp2f(la * LOG2E);
                const float x2 = 2.f * la; const float ser = -x2 * (1.f + x2 * (0.5f + x2 * (0.16666667f + x2 * (0.041666668f + x2 * (0.0083333338f + x2 * 0.0013888889f)))));
                float em = (x2 > -0.25f) ? ser : (1.f - a * a); float mult = __builtin_amdgcn_sqrtf(em);
                if ((rmask >> crow(r, hi)) & 1ull) { a = 0.f; mult = 1.f; }
                aa[nt][r] = a; bb[nt][r] = mult * (ig * xc[r]); }
#pragma unroll
            for (int g = 0; g < 4; ++g) { const float a0 = aa[nt][4 * g], a1 = aa[nt][4 * g + 1], a2 = aa[nt][4 * g + 2], a3 = aa[nt][4 * g + 3];
                const float Ag = (a0 * a1) * (a2 * a3), Bg = ((bb[nt][4 * g] * a1 + bb[nt][4 * g + 1]) * a2 + bb[nt][4 * g + 2]) * a3 + bb[nt][4 * g + 3];
                const float Ao = __shfl_xor(Ag, 32), Bo = __shfl_xor(Bg, 32);
                As[nt][2 * g] = hi ? Ao : Ag; Bs[nt][2 * g] = hi ? Bo : Bg; As[nt][2 * g + 1] = hi ? Ag : Ao; Bs[nt][2 * g + 1] = hi ? Bg : Bo; }
            float At = 1.f, Bt = 0.f;
#pragma unroll
            for (int s = 0; s < 8; ++s) { Bt = As[nt][s] * Bt + Bs[nt][s]; At *= As[nt][s]; }
            if (hi == 0) *(LAS f32x2*)(tot + ((wid * 2 + nt) * 32 + r32) * 2) = (f32x2){At, Bt};
        }
        __syncthreads();
#pragma unroll
        for (int nt = 0; nt < 2; ++nt) {
            float hin = carry[nt], hh = carry[nt];
#pragma unroll
            for (int j = 0; j < 8; ++j) { const f32x2 ab = *(const LAS f32x2*)(tot + ((j * 2 + nt) * 32 + r32) * 2); if (j == wid) hin = hh; hh = ab.x * hh + ab.y; }
            carry[nt] = hh;
            float hseg[4]; float h = hin;
#pragma unroll
            for (int s = 0; s < 8; ++s) { if ((s & 1) == hi) hseg[s >> 1] = h; h = As[nt][s] * h + Bs[nt][s]; }
#pragma unroll
            for (int g = 0; g < 4; ++g) { float hv = hseg[g];
#pragma unroll
                for (int q = 0; q < 4; ++q) { const int r = 4 * g + q; hv = aa[nt][r] * hv + bb[nt][r];
                    YR[(size_t)(b * SEQ + tok0 + crow(r, hi)) * DRNN + 64 * n + 32 * nt + r32] = (bf16)(cvt_pk_bf16(hv, 0.f) & 0xffffu); } }
        }
    }
}
}

namespace att {
constexpr int KSLOT = 12288, VSLOT = 8192, NKS = 3, NVS = 4;
constexpr int L_K = 0, L_V = NKS * KSLOT, L_WS = L_V + NVS * VSLOT, L_OST = L_WS + NWAVES * 256, L_END = L_OST + NWAVES * 4096;
static_assert(L_END <= RING_BYTES, "attention LDS");
__device__ __forceinline__ void glds16(const void* gsrc, unsigned lds_dst) { unsigned keep;
    asm volatile("s_mov_b32 %0, m0\n\ts_mov_b32 m0, %2\n\ts_nop 0\n\tglobal_load_lds_dwordx4 %1, off\n\ts_mov_b32 m0, %0" : "=&s"(keep) : "v"(gsrc), "s"(lds_dst) : "memory"); }
#define ATT_WAIT_BAR(N) asm volatile("s_waitcnt vmcnt(" #N ") lgkmcnt(0)\n\ts_barrier" ::: "memory")
__device__ __forceinline__ float max3f(float a, float b, float c) { return __builtin_fmaxf(__builtin_fmaxf(a, b), c); }
__device__ __forceinline__ void unit(Frame& F, int b, int h, int qb) {
    LAS unsigned char* shm = F.lds; const int lane = lane_id(), wid = F.wave, r32 = lane & 31, hi = lane >> 5;
    const bf16* Q = (const bf16*)(F.ws + WS_Q); const bf16* KN = (const bf16*)(F.ws + WS_KN); const bf16* KR = (const bf16*)(F.ws + WS_KR); const bf16* V = (const bf16*)(F.ws + WS_V); bf16* O = (bf16*)(F.ws + WS_R2);
    const long rowbase = (long)b * SEQ; const int q0 = qb * 256;
    const bf16* Qw = Q + (rowbase + q0 + wid * 32) * 1536 + h * 96;
    const bf16* ksrc = KN + (rowbase + lane) * 1024 + h * 64 + wid * 8;
    const bf16* rsrc = KR + (rowbase + lane) * 32 + (wid & 3) * 8;
    const bf16* vsrc = V + (rowbase + 16 * (wid & 3) + (lane >> 2)) * 1024 + h * 64 + (wid >> 2) * 32 + (lane & 3) * 8;
    const unsigned lds0 = (unsigned)(size_t)shm;
    const unsigned kdst = lds0 + L_K + wid * 1024, rdst = lds0 + L_K + (8 + (wid & 3)) * 1024, vdst = lds0 + L_V + wid * 1024;
#define ATT_DMA(t, ks, vs) do { glds16(ksrc + (long)(t) * 65536, (unsigned)__builtin_amdgcn_readfirstlane(kdst + (ks) * KSLOT)); glds16(rsrc + (long)(t) * 2048, (unsigned)__builtin_amdgcn_readfirstlane(rdst + (ks) * KSLOT)); \
        glds16(vsrc + (long)(t) * 65536, (unsigned)__builtin_amdgcn_readfirstlane(vdst + (vs) * VSLOT)); } while (0)
    const int NTL = 4 * (qb + 1);
    ATT_DMA(0, 0, 0); ATT_DMA(1, 1, 1);
    bf16x8 qr[6];
#pragma unroll
    for (int d0 = 0; d0 < 6; ++d0) qr[d0] = *(const bf16x8*)(Qw + (long)r32 * 1536 + d0 * 16 + hi * 8);
    LAS float* wsf = (LAS float*)(shm + L_WS) + wid * 64;
    float mhat = 0.f, lsum = 0.f; f32x16 o[2]; o[0] = f32x16{}; o[1] = f32x16{}; f32x16 negm = f32x16{};
    const int qrel = wid * 32 + r32;
    const bool grpB = wid >= 4;
    const int jskip = NTL - 4 + (wid >> 1) + 1;
    f32x16 p0, p1;
#define ATT_SMPV(tt, vs) do { \
        const int jb_ = (tt) - (NTL - 4); \
        if (jb_ >= 0) { const int kb0 = 64 * jb_ + 4 * hi; \
            _Pragma("unroll") for (int r = 0; r < 16; ++r) { const int kv = kb0 + (r & 3) + 8 * (r >> 2); if (kv > qrel) p0[r] = -INFINITY; if (kv + 32 > qrel) p1[r] = -INFINITY; } } \
        float ra = max3f(p0[0], p0[1], p1[0]), rb = max3f(p0[2], p0[3], p1[1]); ra = max3f(ra, p1[2], p1[3]); \
        _Pragma("unroll") for (int r = 4; r < 16; r += 4) { ra = max3f(ra, p0[r], p0[r + 1]); rb = max3f(rb, p0[r + 2], p0[r + 3]); ra = max3f(ra, p1[r], p1[r + 1]); rb = max3f(rb, p1[r + 2], p1[r + 3]); } \
        float rm = __builtin_fmaxf(ra, rb); { auto rr = __builtin_amdgcn_permlane32_swap(__float_as_uint(rm), __float_as_uint(rm), false, false); rm = __builtin_fmaxf(__uint_as_float(rr[0]), __uint_as_float(rr[1])); } \
        if ((tt) == 0 || __any(rm > 8.0f)) { const float dl = ((tt) == 0) ? rm : __builtin_fmaxf(rm, 0.f); mhat += dl; \
            _Pragma("unroll") for (int r = 0; r < 16; ++r) { p0[r] -= dl; p1[r] -= dl; negm[r] = -mhat; } \
            const float f = __builtin_amdgcn_exp2f(-dl); lsum *= f; if (hi == 0) wsf[r32] = f; LDS_WAIT(); \
            _Pragma("unroll") for (int r = 0; r < 16; ++r) { const float g = wsf[crow(r, hi)]; o[0][r] *= g; o[1][r] *= g; } } \
        float sacc = 0.f; \
        _Pragma("unroll") for (int r = 0; r < 16; ++r) { p0[r] = __builtin_amdgcn_exp2f(p0[r]); p1[r] = __builtin_amdgcn_exp2f(p1[r]); sacc += p0[r] + p1[r]; } \
        lsum += sacc; \
        u32x4 pw0, pw1, pw2, pw3; \
        pw0 = (u32x4){cvt_pk_bf16(p0[0], p0[1]), cvt_pk_bf16(p0[2], p0[3]), cvt_pk_bf16(p0[4], p0[5]), cvt_pk_bf16(p0[6], p0[7])}; pw1 = (u32x4){cvt_pk_bf16(p0[8], p0[9]), cvt_pk_bf16(p0[10], p0[11]), cvt_pk_bf16(p0[12], p0[13]), cvt_pk_bf16(p0[14], p0[15])}; \
        pw2 = (u32x4){cvt_pk_bf16(p1[0], p1[1]), cvt_pk_bf16(p1[2], p1[3]), cvt_pk_bf16(p1[4], p1[5]), cvt_pk_bf16(p1[6], p1[7])}; pw3 = (u32x4){cvt_pk_bf16(p1[8], p1[9]), cvt_pk_bf16(p1[10], p1[11]), cvt_pk_bf16(p1[12], p1[13]), cvt_pk_bf16(p1[14], p1[15])}; \
        const int vb = (int)(lds0 + L_V + (vs) * VSLOT) + ((lane >> 4) & 1) * 32 + (lane & 3) * 8 + (4 * hi + ((lane & 15) >> 2)) * 64; \
        _Pragma("unroll") for (int d0 = 0; d0 < 2; ++d0) { s16x4 lo[4], hi4[4]; \
            _Pragma("unroll") for (int ks = 0; ks < 4; ++ks) { \
                asm volatile("ds_read_b64_tr_b16 %0,%1 offset:%c2" : "=&v"(lo[ks]) : "v"(vb), "i"(d0 * 4096 + ks * 1024) : "memory"); \
                asm volatile("ds_read_b64_tr_b16 %0,%1 offset:%c2" : "=&v"(hi4[ks]) : "v"(vb), "i"(d0 * 4096 + ks * 1024 + 512) : "memory"); } \
            asm volatile("s_waitcnt lgkmcnt(0)" ::: "memory"); __builtin_amdgcn_sched_barrier(0); \
            o[d0] = __builtin_amdgcn_mfma_f32_32x32x16_bf16(__builtin_bit_cast(bf16x8, pw0), ATT_PK(0), o[d0], 0, 0, 0); \
            o[d0] = __builtin_amdgcn_mfma_f32_32x32x16_bf16(__builtin_bit_cast(bf16x8, pw1), ATT_PK(1), o[d0], 0, 0, 0); \
            o[d0] = __builtin_amdgcn_mfma_f32_32x32x16_bf16(__builtin_bit_cast(bf16x8, pw2), ATT_PK(2), o[d0], 0, 0, 0); \
            o[d0] = __builtin_amdgcn_mfma_f32_32x32x16_bf16(__builtin_bit_cast(bf16x8, pw3), ATT_PK(3), o[d0], 0, 0, 0); } \
    } while (0)
#define ATT_PK(k) (bf16x8){lo[k][0], lo[k][1], lo[k][2], lo[k][3], hi4[k][0], hi4[k][1], hi4[k][2], hi4[k][3]}
    int ks_cur = 0;
    for (int t = 0; t < NTL; ++t) {
        if (t + 1 < NTL) ATT_WAIT_BAR(3); else ATT_WAIT_BAR(0);
        if (t + 2 < NTL) { const int k2 = ks_cur >= 1 ? ks_cur - 1 : 2; ATT_DMA(t + 2, k2, (t + 2) & 3); }
        if (grpB && t > 0 && t - 1 < jskip) ATT_SMPV(t - 1, (t - 1) & 3);
        if (t < jskip) {
            const LAS unsigned char* kb = shm + L_K + ks_cur * KSLOT + hi * 1024 + r32 * 16;
            p0 = negm; p1 = negm;
#pragma unroll
            for (int d0 = 0; d0 < 6; ++d0) { const bf16x8 b0 = *(const LAS bf16x8*)(kb + d0 * 2048), b1 = *(const LAS bf16x8*)(kb + d0 * 2048 + 512);
                p0 = __builtin_amdgcn_mfma_f32_32x32x16_bf16(b0, qr[d0], p0, 0, 0, 0); p1 = __builtin_amdgcn_mfma_f32_32x32x16_bf16(b1, qr[d0], p1, 0, 0, 0); }
            if (!grpB) ATT_SMPV(t, t & 3);
        }
        ks_cur = ks_cur == 2 ? 0 : ks_cur + 1;
    }
    if (grpB && NTL - 1 < jskip) ATT_SMPV(NTL - 1, (NTL - 1) & 3);
#undef ATT_PK
#undef ATT_SMPV
    lsum += __shfl_xor(lsum, 32);
    if (hi == 0) wsf[32 + r32] = lsum; LDS_WAIT();
    float rli[16];
#pragma unroll
    for (int r = 0; r < 16; ++r) rli[r] = __builtin_amdgcn_rcpf(wsf[32 + crow(r, hi)]);
    bf16* Ow = O + (rowbase + q0 + wid * 32) * 1024 + h * 64;
    { LAS bf16* stg = (LAS bf16*)(shm + L_OST) + wid * 2048;
#pragma unroll
      for (int r = 0; r < 16; ++r) { const int orow = crow(r, hi);
#pragma unroll
          for (int d0 = 0; d0 < 2; ++d0) stg[orow * 64 + d0 * 32 + r32] = (bf16)(cvt_pk_bf16(o[d0][r] * rli[r], 0.f) & 0xffffu); }
      LDS_WAIT();
#pragma unroll
      for (int i = 0; i < 4; ++i) { const int row = i * 8 + (lane >> 3), ch = lane & 7; const u32x4 v = *(const LAS u32x4*)(stg + row * 64 + ch * 8); *(u32x4*)(Ow + (long)row * 1024 + ch * 8) = v; } }
    asm volatile("s_waitcnt lgkmcnt(0)\n\ts_barrier" ::: "memory");
#undef ATT_DMA
}
#undef ATT_WAIT_BAR
}
#ifdef DBG_STOP_AFTER
__global__ void dbg_dump_k(float* out, unsigned char* ws, int stage) {
    const size_t NOUT = (size_t)NT * 1024; const size_t nthr = (size_t)gridDim.x * blockDim.x;
    for (size_t j = (size_t)blockIdx.x * blockDim.x + threadIdx.x; j < NOUT; j += nthr) {
        float a = 0.f;
        auto addb = [&](const void* p, size_t n) { const bf16* q = (const bf16*)p; for (size_t i = j; i < n; i += NOUT) a += __uint_as_float((unsigned)q[i] << 16); };
        auto addf = [&](const void* p, size_t n) { const float* q = (const float*)p; for (size_t i = j; i < n; i += NOUT) a += q[i]; };
        if (stage == 0) { addb(ws + WS_WIN, (size_t)35 * MiB / 2); addf(ws + WS_COS, (size_t)NT * 16); addf(ws + WS_SIN, (size_t)NT * 16); addf(ws + WS_CTL + CTL_MOD, 8 * 6144); }
        else if (stage == 1) { addb(ws + WS_R1, (size_t)NT * 1024); }
        else if (stage == 2) { const unsigned w = ((const unsigned*)out)[j]; a = __uint_as_float(w << 16) + __uint_as_float(w & 0xffff0000u);
            addb(ws + WS_R2, (size_t)NT * 1280); addb(ws + WS_LAT, (size_t)NT * 768); addb(ws + WS_KR, (size_t)NT * 32); addf(ws + WS_CTL + CTL_SSQQ, NT); addf(ws + WS_CTL + CTL_SSQKV, NT); }
        else if (stage == 20) { const unsigned w = ((const unsigned*)out)[j]; a = __uint_as_float(w << 16) + __uint_as_float(w & 0xffff0000u); }
        else if (stage == 24) { addb(ws + WS_Q, (size_t)NT * 2048); }
        else if (stage == 21) { addb(ws + WS_R2, (size_t)NT * 1280); }
        else if (stage == 22) { addb(ws + WS_LAT, (size_t)NT * 768); addb(ws + WS_KR, (size_t)NT * 32); }
        else if (stage == 23) { addf(ws + WS_CTL + CTL_SSQQ, NT); addf(ws + WS_CTL + CTL_SSQKV, NT); }
        else if (stage == 3) { addb(ws + WS_R1, (size_t)NT * 1280); addb(ws + WS_Q, (size_t)NT * 1536); addb(ws + WS_KN, (size_t)NT * 1024); addb(ws + WS_V, (size_t)NT * 1024); }
        else if (stage == 4) { addb(ws + WS_R2, (size_t)NT * 1024); }
        else if (stage == 5) { addb(ws + WS_Q, (size_t)NT * 1024); }
        else if (stage == 7) { addb(ws + WS_R1, (size_t)NT * 1024); }
        else if (stage == 8) { addb(ws + WS_Q, (size_t)NT * 2816); addf(ws + WS_R2, (size_t)512 * 4 * 5632); }
        else if (stage == 9) { addb(ws + WS_Q, (size_t)NT * 2816); }
        else continue;
        out[j] = a;
    }
}
#endif
constexpr int N_PHASES = 12;
#ifndef MK_N_LAUNCHES
#define MK_N_LAUNCHES 1
#endif
__global__ void __launch_bounds__(NWAVES * 64, 2) mk_fwd(Args args) {
    extern __shared__ __attribute__((aligned(16))) unsigned char lds_raw[];
    Frame F;
    F.ka = (KArgs)__builtin_amdgcn_kernarg_segment_ptr();
    F.lds = (LAS unsigned char*)lds_raw; F.MISC = (volatile LAS unsigned*)(F.lds + MISC_OFF); F.ws = args.ws;
    F.wave = __builtin_amdgcn_readfirstlane(threadIdx.x >> 6);
    F.G = gridDim.x; { const int bx = blockIdx.x; F.vcu = (F.G % 8 == 0) ? (bx % 8) * (F.G / 8) + bx / 8 : bx; }
    F.out = args.out;
    for (int u = threadIdx.x; u < (LDS_BYTES - LDSCTL_OFF) / 4; u += NWAVES * 64) ((LAS unsigned*)(F.lds + LDSCTL_OFF))[u] = 0u;
    __syncthreads();
    unsigned char* ws = args.ws;
    XcdBarrier bar; bar.bar = (unsigned*)(ws + WS_CTL + CTL_BAR); bar.x = 0; bar.st = nullptr;
    if (MK_N_LAUNCHES == 1) bar = xcd_barrier_post((unsigned*)(ws + WS_CTL + CTL_BAR), F.MISC + 8);
    const int lo = args.ph_lo, hi = args.ph_hi;
#ifndef MK_PHASE_MASK
#define MK_PHASE_MASK 0xfff
#endif
#define IN(k) (((MK_PHASE_MASK >> (k)) & 1) && lo <= (k) && (k) < hi)
#ifndef DBG_REPEAT_PHASE
#define DBG_REPEAT_PHASE -1
#endif
#define NREP(k) ((k) == DBG_REPEAT_PHASE ? 2 : 1)
#define SEAM(k) do { if (IN(k) && IN((k) + 1)) xcd_barrier(bar); } while (0)
    bf16* WIN = (bf16*)(ws + WS_WIN); bf16* WUQ = (bf16*)(ws + WS_WUQ); bf16* WUKV = (bf16*)(ws + WS_WUKV); bf16* WPR = (bf16*)(ws + WS_WPR); bf16* WPM = (bf16*)(ws + WS_WPM);
    bf16* WOUT = (bf16*)(ws + WS_WOUT); bf16* WUP = (bf16*)(ws + WS_WUP); bf16* WDN = (bf16*)(ws + WS_WDN);
    float* cosT = (float*)(ws + WS_COS); float* sinT = (float*)(ws + WS_SIN);
    float* mod = (float*)(ws + WS_CTL + CTL_MOD); float* ssq_q = (float*)(ws + WS_CTL + CTL_SSQQ); float* ssq_kv = (float*)(ws + WS_CTL + CTL_SSQKV);
    bf16* R1 = (bf16*)(ws + WS_R1); bf16* R2 = (bf16*)(ws + WS_R2); bf16* LAT = (bf16*)(ws + WS_LAT); bf16* QB = (bf16*)(ws + WS_Q); bf16* KNB = (bf16*)(ws + WS_KN); bf16* VB = (bf16*)(ws + WS_V); bf16* KRB = (bf16*)(ws + WS_KR);
#ifdef DBG_SG_IN_WS
    bf16* SG = (bf16*)(ws + WS_Q);
#else
    bf16* SG = (bf16*)F.out;
#endif
    bf16* MG = QB; bf16* ACT = QB; float* SIDE = (float*)R2;
    LAS unsigned char* ring = F.lds + RING_OFF;

    if (IN(0)) { p0_prologue(F); } SEAM(0);
    if (IN(1)) for (int rep_ = 0; rep_ < NREP(1); ++rep_) { norm_rows_mod(F, INP(0), R1, INP(5), 1024, 0); } SEAM(1);
    if (IN(2)) { pg8::Gemm g{R1, WIN, DM, DM, DM}; pg8::StaticOrder S; S.init(NT, 4096, F.G, (int)blockIdx.x);
        EpiIn E{R2, LAT, KRB, SG, ssq_q, ssq_kv, cosT, sinT};
        pg8::gemm_phase<EpiIn, pg8::StaticOrder, true, true>(ring, g, S, E, F.wave); } SEAM(2);
    if (IN(3)) for (int rep_ = 0; rep_ < NREP(3); ++rep_) {
#ifndef NO_RNN
        for (int u = F.vcu; u < NB * 20; u += F.G) rnn::unit(F, u / 20, u % 20);
        __syncthreads();
#endif
#ifndef NO_QKV
#ifndef NO_Q
        { pg8::Gemm g{LAT, WUQ, 768, QL, QL}; pg8::StaticOrder S; S.init(NT, 1536, F.G, (int)blockIdx.x); EpiQ E{QB, ssq_q, cosT, sinT};
          pg8::gemm_phase<EpiQ, pg8::StaticOrder, true, true>(ring, g, S, E, F.wave); }
#endif
#ifndef NO_KV
        { pg8::Gemm g{LAT + QL, WUKV, 768, KVL, KVL}; pg8::StaticOrder S; S.init(NT, 2048, F.G, (int)blockIdx.x); EpiKV E{KNB, VB, ssq_kv};
          pg8::gemm_phase<EpiKV, pg8::StaticOrder, true, true>(ring, g, S, E, F.wave); }
#endif
#endif
    } SEAM(3);
    if (IN(4)) for (int rep_ = 0; rep_ < NREP(4); ++rep_) {
        for (int idx = F.vcu; idx < 2048; idx += F.G) { const int v = idx & 255, i = idx >> 8, bh = v >> 1, s = v & 1; const int qb = 2 * i + ((i & 1) ? 1 - s : s);
            att::unit(F, bh >> 4, bh & 15, qb); }
    } SEAM(4);
    if (IN(5)) for (int rep_ = 0; rep_ < NREP(5); ++rep_) {
        { pg8::Gemm g{R1, WPR, DRNN, DRNN, DRNN}; pg8::StaticOrder S; S.init(NT, DM, F.G, (int)blockIdx.x); EpiMerge<false> E{MG, SG, 0};
          pg8::gemm_phase<EpiMerge<false>, pg8::StaticOrder, true, true>(ring, g, S, E, F.wave); }
#ifndef DBG_NO_MERGE_B
        { pg8::Gemm g{R2, WPM, DM, DM, DM}; pg8::StaticOrder S; S.init(NT, DM, F.G, (int)blockIdx.x); EpiMerge<true> E{MG, SG, 1024};
          pg8::gemm_phase<EpiMerge<true>, pg8::StaticOrder, true, true>(ring, g, S, E, F.wave); }
#endif
    } SEAM(5);
    if (IN(6)) for (int rep_ = 0; rep_ < NREP(6); ++rep_) { pg8::Gemm g{MG, WOUT, DM, DM, DM}; pg8::StaticOrder S; S.init(NT, DM, F.G, (int)blockIdx.x); EpiRes E{INP(0), F.out, mod, 2048};
        pg8::gemm_phase<EpiRes, pg8::StaticOrder, true, true>(ring, g, S, E, F.wave); } SEAM(6);
    if (IN(7)) for (int rep_ = 0; rep_ < NREP(7); ++rep_) { norm_rows_mod(F, F.out, R1, INP(21), 4096, 3072); } SEAM(7);
    if (IN(8)) for (int rep_ = 0; rep_ < NREP(8); ++rep_) { pg8::Gemm g{R1, WUP, DM, DM, DM}; pg8::StaticOrder S; S.init(NT, NUP, F.G, (int)blockIdx.x); EpiUp E{ACT, SIDE, INP(23), INP(24)};
        pg8::gemm_phase<EpiUp, pg8::StaticOrder, true, true>(ring, g, S, E, F.wave); } SEAM(8);
    if (IN(9)) for (int rep_ = 0; rep_ < NREP(9); ++rep_) { ffn_fixup(F, ACT, SIDE, INP(23), INP(24)); } SEAM(9);
    if (IN(10)) { pg8::Gemm g{ACT, WDN, DFF, DFF, DFF}; pg8::StaticOrder S; S.init(NT, DM, F.G, (int)blockIdx.x); EpiRes E{F.out, F.out, mod, 5120};
        pg8::gemm_phase<EpiRes, pg8::StaticOrder, true, true>(ring, g, S, E, F.wave); } SEAM(10);
    if (IN(11)) { norm_rows_final(F, F.out, INP(26)); }
#undef IN
#undef SEAM
}

extern "C" void kernel_launch(void* const* d_in, const int* in_sizes, int n_in, void* d_out, int out_size, void* d_ws, size_t ws_size, hipStream_t stream) {
    static int grid = 0;
    if (grid == 0) {
        if (n_in != 27 || in_sizes[0] != NT * DM || out_size != NT * DM || ws_size < WS_END) { fprintf(stderr, "kernel_launch: unexpected shapes (n_in %d, in0 %d, out %d, ws %zu); nothing launched\n", n_in, n_in > 0 ? in_sizes[0] : -1, out_size, ws_size); grid = -1; return; }
        int dev = 0, cus = 0, per_cu = 0;
        if (hipGetDevice(&dev) != hipSuccess || hipDeviceGetAttribute(&cus, hipDeviceAttributeMultiprocessorCount, dev) != hipSuccess) { grid = -1; return; }
        if (hipFuncSetAttribute((const void*)mk_fwd, hipFuncAttributeMaxDynamicSharedMemorySize, LDS_BYTES) != hipSuccess) { fprintf(stderr, "kernel_launch: hipFuncSetAttribute failed\n"); grid = -1; return; }
        if (hipOccupancyMaxActiveBlocksPerMultiprocessor(&per_cu, (const void*)mk_fwd, NWAVES * 64, LDS_BYTES) != hipSuccess || per_cu < 1) { fprintf(stderr, "kernel_launch: occupancy query says %d blocks/CU\n", per_cu); per_cu = 1; }
        (void)hipGetLastError();
        grid = cus;
    }
    if (grid < 0) return;
    (void)hipMemsetAsync((char*)d_ws + WS_CTL, 0, CTL_ZERO_BYTES, stream);
    Args a{};
    for (int i = 0; i < 27; ++i) a.in[i] = (const float*)d_in[i];
    a.out = (float*)d_out; a.ws = (unsigned char*)d_ws;
#ifdef DBG_STOP_AFTER
#ifndef DBG_STAGE
#define DBG_STAGE DBG_STOP_AFTER
#endif
    for (int p = 0; p <= DBG_STOP_AFTER; ++p) { a.ph_lo = p; a.ph_hi = p + 1; hipLaunchKernelGGL(mk_fwd, dim3(grid), dim3(NWAVES * 64), LDS_BYTES, stream, a); }
    hipLaunchKernelGGL(dbg_dump_k, dim3(2048), dim3(256), 0, stream, (float*)d_out, (unsigned char*)d_ws, (int)DBG_STAGE);
#elif MK_N_LAUNCHES == 1
    a.ph_lo = 0; a.ph_hi = N_PHASES;
    hipLaunchKernelGGL(mk_fwd, dim3(grid), dim3(NWAVES * 64), LDS_BYTES, stream, a);
#else
    for (int p = 0; p < N_PHASES; ++p) { a.ph_lo = p; a.ph_hi = p + 1; hipLaunchKernelGGL(mk_fwd, dim3(grid), dim3(NWAVES * 64), LDS_BYTES, stream, a); }
#endif
}
```

```cpp
#include <hip/hip_runtime.h>
#include <cstdio>
#include <cstdint>
#include <cmath>
namespace pg8 {
#define PG8_LAS __attribute__((address_space(3)))
typedef unsigned short bf16_t;
typedef short bf16x8 __attribute__((ext_vector_type(8)));
typedef float f32x4 __attribute__((ext_vector_type(4)));
typedef float f32x2 __attribute__((ext_vector_type(2)));
typedef unsigned u32x4 __attribute__((ext_vector_type(4)));
typedef unsigned u32x2 __attribute__((ext_vector_type(2)));
constexpr int BM = 256, BK = 64, HALF = 128, HTB = HALF * BK * 2  , STAGE_BYTES = 8 * HTB, NXCD = 8, WGM = 8;

__host__ __device__ __forceinline__ int lds_byte(int r, int c) { const int st = (r >> 4) * 2 + (c >> 5), rr = r & 15, cc = c & 31, ob = rr * 64 + cc * 2; return st * 1024 + (ob ^ (((ob >> 9) & 1) << 5)); }
__host__ __device__ __forceinline__ void stage_rc(int b, int& R, int& C) { const int st = b / 1024, sb = b % 1024, swz = sb ^ (((sb >> 9) & 1) << 5); R = (st >> 1) * 16 + swz / 64; C = (st & 1) * 32 + (swz % 64) / 2; }
__host__ __device__ __forceinline__ int perm32(int rho) { const int n = rho >> 4, i = rho & 15; return 8 * (i >> 2) + 4 * n + (i & 3); }

struct Unit { int pm, pn; };
struct Gemm { const bf16_t* A; const bf16_t* Bt; int lda, ldb, K; };

struct StaticOrder {
    int nM, nN, nwg, G, c;
    __host__ __device__ void init(int M, int N, int G_, int c_) { nM = M / BM; nN = N / BM; nwg = nM * nN; G = G_; c = c_; }
    __host__ __device__ bool next(int i, Unit& u) const {
        const long L = (long)i * G + c; if (L >= nwg) return false;
        int wgid = (int)L; { const int q = nwg / NXCD, r = nwg % NXCD, xcd = wgid % NXCD, off = wgid / NXCD; wgid = (xcd < r ? xcd * (q + 1) : r * (q + 1) + (xcd - r) * q) + off; }
        const int nig = WGM * nN, gid = wgid / nig, fm = gid * WGM, gsz = (nM - fm) < WGM ? (nM - fm) : WGM;
        u.pm = fm + ((wgid % nig) % gsz); u.pn = (wgid % nig) / gsz; return true;
    }
};
typedef __bf16 bf16x2_t __attribute__((ext_vector_type(2)));
__device__ __forceinline__ unsigned cvt_pk_bf16(float lo, float hi) { f32x2 v = {lo, hi}; bf16x2_t b = __builtin_convertvector(v, bf16x2_t); return __builtin_bit_cast(unsigned, b); }

template <class Epi, class Sched, bool ALIGN_EPI = false, bool SP2 = false>
__device__ __forceinline__ void gemm_phase(PG8_LAS unsigned char* lds, const Gemm g, const Sched& S, const Epi& E, const int wid_) {
    int z_; asm volatile("v_mov_b32 %0, 0" : "=v"(z_));
    const int wid = wid_, lane = __builtin_amdgcn_mbcnt_hi(~0u, __builtin_amdgcn_mbcnt_lo(~0u, z_)), tid = wid * 64 + lane, wr = wid >> 2, wc = wid & 3, fr = lane & 15, fq = lane >> 4;
    const int K = g.K, nt = K / BK;
    unsigned voffA[2], voffB[2];
#pragma unroll
    for (int i = 0; i < 2; ++i) { int R, C; stage_rc(tid * 16 + i * 8192, R, C); const int Rb = Epi::PERM ? ((R & ~31) + perm32(R & 31)) : R;
        voffA[i] = (unsigned)(R * g.lda + C) * 2u; voffB[i] = (unsigned)(Rb * g.ldb + C) * 2u; }
    const size_t kstep = (size_t)(BK * 2);
    const size_t hA = (size_t)HALF * g.lda * 2, hB = (size_t)HALF * g.ldb * 2;
    const size_t tA = 2 * hA, tB = 2 * hB;
    const unsigned ldsw = (unsigned)wid * 1024u;
    const int aoff = lds_byte(wr * 64 + fr, fq * 8), boff = lds_byte(wc * 32 + fr, fq * 8);
#define PG8_SA(b, h) (((b) * 2 + (h)) * HTB)
#define PG8_SB(b, h) ((4 + (b) * 2 + (h)) * HTB)
#define PG8_STAGE(bufoff, gbase, voff) do { _Pragma("unroll") for (int _i = 0; _i < 2; ++_i) \
        __builtin_amdgcn_global_load_lds((const unsigned*)((const char*)(gbase) + (voff)[_i]), (PG8_LAS unsigned*)(lds + (bufoff) + ldsw + _i * 8192), 16, 0, 0); } while (0)
#define PG8_LDA(dst, b, h) do { _Pragma("unroll") for (int m = 0; m < 4; ++m) _Pragma("unroll") for (int k = 0; k < 2; ++k) dst[m][k] = *(const PG8_LAS bf16x8*)(lds + PG8_SA(b, h) + aoff + m * 2048 + k * 1024); } while (0)
#define PG8_LDB(dst, b, h) do { _Pragma("unroll") for (int n = 0; n < 2; ++n) _Pragma("unroll") for (int k = 0; k < 2; ++k) dst[n][k] = *(const PG8_LAS bf16x8*)(lds + PG8_SB(b, h) + boff + n * 2048 + k * 1024); } while (0)
#define PG8_MMA(ai, bj, At, Bt) do { __builtin_amdgcn_s_setprio(1); _Pragma("unroll") for (int m = 0; m < 4; ++m) _Pragma("unroll") for (int n = 0; n < 2; ++n) _Pragma("unroll") for (int k = 0; k < 2; ++k) \
        acc[ai][bj][m][n] = __builtin_amdgcn_mfma_f32_16x16x32_bf16(Bt[n][k], At[m][k], acc[ai][bj][m][n], 0, 0, 0); __builtin_amdgcn_s_setprio(0); } while (0)
#define PG8_WAIT_V(n) asm volatile("s_waitcnt vmcnt(" #n ")" ::: "memory")
#define PG8_WAIT_L(n) asm volatile("s_waitcnt lgkmcnt(" #n ")" ::: "memory")
#define PG8_BAR __builtin_amdgcn_s_barrier()
#define PG8_SCHED __builtin_amdgcn_sched_barrier(0)
    Unit cur, nxt; int ui = 0;
    if (!S.next(0, cur)) return;
    f32x4 acc[2][2][4][2];
#pragma unroll
    for (int a = 0; a < 2; ++a)
#pragma unroll
        for (int b = 0; b < 2; ++b)
#pragma unroll
            for (int m = 0; m < 4; ++m)
#pragma unroll
                for (int n = 0; n < 2; ++n) acc[a][b][m][n] = (f32x4){0.f, 0.f, 0.f, 0.f};
    bf16x8 At[4][2], B0[2][2], B1[2][2];
    const char* cA = (const char*)g.A + (size_t)cur.pm * tA; const char* cB = (const char*)g.Bt + (size_t)cur.pn * tB;
    if constexpr (SP2) {
        PG8_STAGE(PG8_SB(0, 0), cB, voffB); PG8_STAGE(PG8_SB(0, 1), cB + hB, voffB); PG8_STAGE(PG8_SA(0, 0), cA, voffA); PG8_STAGE(PG8_SA(0, 1), cA + hA, voffA);
        if (wr == 1) PG8_BAR;
        PG8_WAIT_V(2); PG8_BAR;
        PG8_STAGE(PG8_SB(1, 0), cB + kstep, voffB); PG8_STAGE(PG8_SA(1, 0), cA + kstep, voffA); PG8_STAGE(PG8_SB(1, 1), cB + hB + kstep, voffB);
        PG8_WAIT_V(6); PG8_BAR;
    } else {
        PG8_STAGE(PG8_SB(0, 0), cB, voffB); PG8_STAGE(PG8_SA(0, 0), cA, voffA); PG8_STAGE(PG8_SB(0, 1), cB + hB, voffB); PG8_STAGE(PG8_SA(0, 1), cA + hA, voffA);
        if (wr == 1) PG8_BAR;
        PG8_WAIT_V(4); PG8_BAR;
        PG8_STAGE(PG8_SB(1, 0), cB + kstep, voffB); PG8_STAGE(PG8_SA(1, 0), cA + kstep, voffA); PG8_STAGE(PG8_SB(1, 1), cB + hB + kstep, voffB);
        PG8_WAIT_V(6); PG8_BAR;
    }
    for (;;) {
        const bool has_next = S.next(ui + 1, nxt);
        const char* nA = has_next ? (const char*)g.A + (size_t)nxt.pm * tA : cA; const char* nB = has_next ? (const char*)g.Bt + (size_t)nxt.pn * tB : cB;
        for (int t = 0; t < nt; t += 2) {
            const bool last = (t == nt - 2);
            const char* a1 = cA + (size_t)(t + 1) * kstep;
            const char* a2 = last ? nA : cA + (size_t)(t + 2) * kstep; const char* b2 = last ? nB : cB + (size_t)(t + 2) * kstep;
            const char* a3 = a2 + kstep; const char* b3 = b2 + kstep;
            if constexpr (SP2) {
            PG8_LDB(B0, 0, 0); PG8_LDB(B1, 0, 1); PG8_SCHED; PG8_LDA(At, 0, 0); PG8_STAGE(PG8_SA(1, 1), a1 + hA, voffA);
            PG8_WAIT_V(8); PG8_WAIT_L(0); PG8_BAR; PG8_MMA(0, 0, At, B0); PG8_MMA(0, 1, At, B1); PG8_BAR; PG8_SCHED;
            PG8_LDA(At, 0, 1); PG8_STAGE(PG8_SB(0, 0), b2, voffB); PG8_STAGE(PG8_SB(0, 1), b2 + hB, voffB); PG8_STAGE(PG8_SA(0, 0), a2, voffA);
            PG8_WAIT_V(8); PG8_WAIT_L(0); PG8_BAR; PG8_MMA(1, 0, At, B0); PG8_MMA(1, 1, At, B1); PG8_BAR; PG8_SCHED;
            PG8_LDB(B0, 1, 0); PG8_LDB(B1, 1, 1); PG8_SCHED; PG8_LDA(At, 1, 0); PG8_STAGE(PG8_SA(0, 1), a2 + hA, voffA);
            PG8_WAIT_V(8); PG8_WAIT_L(0); PG8_BAR; PG8_MMA(0, 0, At, B0); PG8_MMA(0, 1, At, B1); PG8_BAR; PG8_SCHED;
            PG8_LDA(At, 1, 1); PG8_STAGE(PG8_SB(1, 0), b3, voffB); PG8_STAGE(PG8_SB(1, 1), b3 + hB, voffB); PG8_STAGE(PG8_SA(1, 0), a3, voffA);
            PG8_WAIT_V(8); PG8_WAIT_L(0); PG8_BAR; PG8_MMA(1, 0, At, B0); PG8_MMA(1, 1, At, B1); PG8_BAR; PG8_SCHED;
            } else {
            PG8_LDB(B0, 0, 0); PG8_SCHED; PG8_LDA(At, 0, 0); PG8_STAGE(PG8_SA(1, 1), a1 + hA, voffA);
            PG8_WAIT_L(8); PG8_BAR; PG8_WAIT_L(0); PG8_MMA(0, 0, At, B0); PG8_BAR; PG8_SCHED;
            PG8_LDB(B1, 0, 1); PG8_STAGE(PG8_SB(0, 0), b2, voffB);
            PG8_BAR; PG8_WAIT_L(0); PG8_MMA(0, 1, At, B1); PG8_BAR;
            PG8_LDA(At, 0, 1); PG8_STAGE(PG8_SA(0, 0), a2, voffA);
            PG8_BAR; PG8_WAIT_L(0); PG8_MMA(1, 0, At, B0); PG8_BAR; PG8_SCHED;
            PG8_STAGE(PG8_SB(0, 1), b2 + hB, voffB);
            PG8_WAIT_V(6); PG8_BAR; PG8_MMA(1, 1, At, B1); PG8_BAR;
            PG8_LDB(B0, 1, 0); PG8_SCHED; PG8_LDA(At, 1, 0); PG8_STAGE(PG8_SA(0, 1), a2 + hA, voffA);
            PG8_WAIT_L(8); PG8_BAR; PG8_WAIT_L(0); PG8_MMA(0, 0, At, B0); PG8_BAR; PG8_SCHED;
            PG8_LDB(B1, 1, 1); PG8_STAGE(PG8_SB(1, 0), b3, voffB);
            PG8_BAR; PG8_WAIT_L(0); PG8_MMA(0, 1, At, B1); PG8_BAR;
            PG8_LDA(At, 1, 1); PG8_STAGE(PG8_SA(1, 0), a3, voffA);
            PG8_BAR; PG8_WAIT_L(0); PG8_MMA(1, 0, At, B0); PG8_BAR; PG8_SCHED;
            PG8_STAGE(PG8_SB(1, 1), b3 + hB, voffB);
            PG8_WAIT_V(6); PG8_BAR; PG8_MMA(1, 1, At, B1); PG8_BAR;
            }
        }
        if constexpr (ALIGN_EPI) { if (wr == 0) PG8_BAR; }
        E(acc, cur, wr, wc);
        if (!has_next) break;
#pragma unroll
        for (int a = 0; a < 2; ++a)
#pragma unroll
            for (int b = 0; b < 2; ++b)
#pragma unroll
                for (int m = 0; m < 4; ++m)
#pragma unroll
                    for (int n = 0; n < 2; ++n) acc[a][b][m][n] = (f32x4){0.f, 0.f, 0.f, 0.f};
        cur = nxt; cA = nA; cB = nB; ++ui;
        if constexpr (ALIGN_EPI) { if (wr == 1) PG8_BAR; }
    }
    PG8_WAIT_V(0);
    if constexpr (!ALIGN_EPI) { if (wr == 0) PG8_BAR; }
    PG8_BAR;
#undef PG8_SA
#undef PG8_SB
#undef PG8_STAGE
#undef PG8_LDA
#undef PG8_LDB
#undef PG8_MMA
#undef PG8_WAIT_V
#undef PG8_WAIT_L
#undef PG8_BAR
#undef PG8_SCHED
}
}
#define LAS __attribute__((address_space(3)))
typedef unsigned short bf16;
typedef float f32x4 __attribute__((ext_vector_type(4)));
typedef float f32x2 __attribute__((ext_vector_type(2)));
typedef float f32x16 __attribute__((ext_vector_type(16)));
typedef short bf16x8 __attribute__((ext_vector_type(8)));
typedef short s16x4 __attribute__((ext_vector_type(4)));
typedef unsigned u32x4 __attribute__((ext_vector_type(4)));
typedef unsigned u32x2 __attribute__((ext_vector_type(2)));
using pg8::Unit; using pg8::cvt_pk_bf16;
#define RLX_AGENT __ATOMIC_RELAXED, __HIP_MEMORY_SCOPE_AGENT
#define LDS_WAIT() asm volatile("s_waitcnt lgkmcnt(0)" ::: "memory")
#define VM_WAIT() asm volatile("s_waitcnt vmcnt(0)" ::: "memory")

constexpr int NB = 8, SEQ = 4096, NT = NB * SEQ, DM = 1024, DRNN = 1280, QL = 384, KVL = 256, DIN = 4000, NH = 16, DFF = 2816, NUP = 2 * DFF;
constexpr float EPS = 1e-6f;
constexpr float LOG2E = 1.4426950408889634f;
constexpr float QSCALE = 0.10206207261596575f * 1.4426950408889634f;

constexpr size_t MiB = 1u << 20;
constexpr size_t WS_CTL = 0, CTL_ZERO_BYTES = 1 * MiB;
constexpr size_t CTL_BAR = 16384;
constexpr size_t CTL_MOD = 65536;
constexpr size_t CTL_SSQQ = 262144, CTL_SSQKV = 393216;
constexpr size_t WS_WIN = 1 * MiB, WS_WUQ = 9 * MiB, WS_WUKV = 11 * MiB, WS_WPR = 12 * MiB, WS_WPM = 15 * MiB, WS_WOUT = 17 * MiB, WS_WUP = 19 * MiB, WS_WDN = 30 * MiB;
constexpr size_t WS_COS = 36 * MiB, WS_SIN = 38 * MiB;
constexpr size_t WS_R1 = 40 * MiB;
constexpr size_t WS_R2 = 120 * MiB;
constexpr size_t WS_LAT = 200 * MiB;
constexpr size_t WS_Q = 248 * MiB;
constexpr size_t WS_KN = 344 * MiB, WS_V = 408 * MiB, WS_KR = 472 * MiB, WS_END = 474 * MiB;

__device__ __forceinline__ u32x4 pack8(f32x4 a, f32x4 b) { u32x4 w; w.x = cvt_pk_bf16(a[0], a[1]); w.y = cvt_pk_bf16(a[2], a[3]); w.z = cvt_pk_bf16(b[0], b[1]); w.w = cvt_pk_bf16(b[2], b[3]); return w; }
__device__ __forceinline__ float bflo(unsigned w) { return __uint_as_float(w << 16); }
__device__ __forceinline__ float bfhi(unsigned w) { return __uint_as_float(w & 0xffff0000u); }
__device__ __forceinline__ float fsigmoid(float v) { return __builtin_amdgcn_rcpf(1.f + __builtin_amdgcn_exp2f(-LOG2E * v)); }
__device__ __forceinline__ float sumsq4(f32x4 v) { return (v[0] * v[0] + v[1] * v[1]) + (v[2] * v[2] + v[3] * v[3]); }
__device__ __forceinline__ float wave_sum(float v) {
#pragma unroll
    for (int o = 1; o < 64; o <<= 1) v += __shfl_xor(v, o);
    return v;
}

#define XB_TMO      128
#define XB_XCNT(j)  (256  + 64 * (j))
#define XB_XSUB(j)  (1280 + 64 * (j))
#define XB_XGEN(j)  (2304 + 64 * (j))
#define XB_TOP      3328
#define XB_TOPGEN   3392
#define XCD_BAR_WORDS 3456
#define XB_SPIN_CAP (1u << 18)
__device__ __forceinline__ unsigned xb_ld(unsigned* p)              { return __hip_atomic_load(p, __ATOMIC_RELAXED, __HIP_MEMORY_SCOPE_AGENT); }
__device__ __forceinline__ unsigned xb_add(unsigned* p, unsigned v) { return __hip_atomic_fetch_add(p, v, __ATOMIC_RELAXED, __HIP_MEMORY_SCOPE_AGENT); }
__device__ __forceinline__ unsigned xb_xcc_id() { return (unsigned)__builtin_amdgcn_s_getreg((3 << 11) | 20) & 0xFu; }
#define XB_SPIN(cond, bar) do { unsigned _sp = 0; while (cond) { __builtin_amdgcn_s_sleep(1); \
    if ((++_sp & 255u) == 0u) { if (xb_ld(&(bar)[XB_TMO])) break; if (_sp > XB_SPIN_CAP) { atomicAdd(&(bar)[XB_TMO], 1u); break; } } } } while (0)
struct XcdBarrier { unsigned* bar; unsigned x; volatile LAS unsigned* st; };
__device__ __forceinline__ XcdBarrier xcd_barrier_post(unsigned* bar, volatile LAS unsigned* st) {
    XcdBarrier b; b.bar = bar; b.x = xb_xcc_id(); b.st = st;
    if (threadIdx.x == 0) (void)xb_add(&bar[XB_XCNT(b.x)], 1u);
    return b;
}
__device__ __forceinline__ void xcd_barrier_complete(unsigned* bar, unsigned x, unsigned& nloc, unsigned& nx) {
    const unsigned G = gridDim.x * gridDim.y * gridDim.z;
    unsigned sum, cnt, mine, sp = 0u;
    for (;;) {
        sum = 0u; cnt = 0u; mine = 0u;
#pragma unroll
        for (unsigned j = 0; j < 16; ++j) { const unsigned c = xb_ld(&bar[XB_XCNT(j)]); sum += c; cnt += (c > 0u) ? 1u : 0u; mine = (j == x) ? c : mine; }
        if (sum == G) break;
        __builtin_amdgcn_s_sleep(1);
        if ((++sp & 255u) == 0u) { if (xb_ld(&bar[XB_TMO])) break; if (sp > XB_SPIN_CAP) { atomicAdd(&bar[XB_TMO], 1u); break; } }
    }
    nloc = mine > 0u ? mine : 1u; nx = cnt > 0u ? cnt : 1u;
}
__device__ __forceinline__ void xcd_barrier(const XcdBarrier& b) {
    asm volatile("s_waitcnt vmcnt(0)" ::: "memory");
    __syncthreads();
    if (threadIdx.x == 0) {
        unsigned* bar = b.bar;
        __builtin_amdgcn_s_waitcnt(0);
        unsigned nloc = b.st[0], nx = b.st[1];
        if (nloc == 0u) { xcd_barrier_complete(bar, b.x, nloc, nx); b.st[0] = nloc; b.st[1] = nx; }
        const unsigned old = xb_add(&bar[XB_XSUB(b.x)], 1u);
        const unsigned gen = old / nloc;
        if (old + 1u == (gen + 1u) * nloc) {
            __builtin_amdgcn_fence(__ATOMIC_RELEASE, "agent");
            asm volatile("s_waitcnt vmcnt(0)" ::: "memory");
            const unsigned og = xb_add(&bar[XB_TOP], 1u);
            const unsigned tg = og / nx;
            if (og + 1u == (tg + 1u) * nx) xb_add(&bar[XB_TOPGEN], 1u);
            else XB_SPIN(xb_ld(&bar[XB_TOPGEN]) == tg, bar);
            __builtin_amdgcn_fence(__ATOMIC_ACQUIRE, "agent");
            xb_add(&bar[XB_XGEN(b.x)], 1u);
            asm volatile("s_waitcnt vmcnt(0)" ::: "memory");
        } else {
            XB_SPIN(xb_ld(&bar[XB_XGEN(b.x)]) == gen, bar);
            __builtin_amdgcn_fence(__ATOMIC_ACQUIRE, "agent");
            asm volatile("s_waitcnt vmcnt(0)" ::: "memory");
        }
    }
    __syncthreads();
}
__device__ __forceinline__ void rope8(f32x4& v0, f32x4& v1, const float* cosT, const float* sinT, int row, int fq) {
    const float* cp = cosT + (size_t)row * 16 + 4 * fq; const float* sp = sinT + (size_t)row * 16 + 4 * fq;
    { const f32x2 c = *(const f32x2*)cp, s = *(const f32x2*)sp; const float x0 = v0[0], x1 = v0[1], x2 = v0[2], x3 = v0[3];
      v0[0] = x0 * c[0] - x1 * s[0]; v0[1] = x1 * c[0] + x0 * s[0]; v0[2] = x2 * c[1] - x3 * s[1]; v0[3] = x3 * c[1] + x2 * s[1]; }
    asm volatile("" : "+v"(v0));
    { const f32x2 c = *(const f32x2*)(cp + 2), s = *(const f32x2*)(sp + 2); const float x0 = v1[0], x1 = v1[1], x2 = v1[2], x3 = v1[3];
      v1[0] = x0 * c[0] - x1 * s[0]; v1[1] = x1 * c[0] + x0 * s[0]; v1[2] = x2 * c[1] - x3 * s[1]; v1[3] = x3 * c[1] + x2 * s[1]; }
}
struct EpiIn {
    static constexpr bool PERM = true;
    bf16 *XR, *LAT, *KR, *SG; float *ssq_q, *ssq_kv; const float *cosT, *sinT;
    __device__ __forceinline__ void operator()(f32x4 (&acc)[2][2][4][2], const Unit& u, int wr, int wc) const {
        int z_; asm volatile("v_mov_b32 %0, 0" : "=v"(z_)); const int lane_ = __builtin_amdgcn_mbcnt_hi(~0u, __builtin_amdgcn_mbcnt_lo(~0u, z_)), fr = lane_ & 15, fq = lane_ >> 4;
        const int row0 = u.pm * 256 + wr * 64 + fr, pn = u.pn, cw = wc * 32 + 8 * fq;
        if (pn < 5) {
#pragma unroll
            for (int ai = 0; ai < 2; ++ai)
#pragma unroll
                for (int m = 0; m < 4; ++m) { bf16* rowp = XR + (size_t)(row0 + ai * 128 + m * 16) * DRNN + pn * 256 + cw;
#pragma unroll
                    for (int bj = 0; bj < 2; ++bj) *(u32x4*)(rowp + bj * 128) = pack8(acc[ai][bj][m][0], acc[ai][bj][m][1]); }
        } else if (pn < 8) {
            const int ct = (pn - 5) * 256;
#pragma unroll
            for (int ai = 0; ai < 2; ++ai)
#pragma unroll
                for (int m = 0; m < 4; ++m) { const int row = row0 + ai * 128 + m * 16; bf16* rowp = LAT + (size_t)row * 768 + ct + cw;
                    float s0 = sumsq4(acc[ai][0][m][0]) + sumsq4(acc[ai][0][m][1]), s1 = sumsq4(acc[ai][1][m][0]) + sumsq4(acc[ai][1][m][1]);
                    *(u32x4*)(rowp) = pack8(acc[ai][0][m][0], acc[ai][0][m][1]);
                    if (pn != 7) *(u32x4*)(rowp + 128) = pack8(acc[ai][1][m][0], acc[ai][1][m][1]);
                    else if (wc == 0) { f32x4 v0 = acc[ai][1][m][0], v1 = acc[ai][1][m][1]; rope8(v0, v1, cosT, sinT, row, fq); *(u32x4*)(KR + (size_t)row * 32 + 8 * fq) = pack8(v0, v1); }
                    if (pn == 5) { s0 += s1; s1 = 0.f; }
                    s0 += __shfl_xor(s0, 16); s0 += __shfl_xor(s0, 32); s1 += __shfl_xor(s1, 16); s1 += __shfl_xor(s1, 32);
                    if (fq == 0) { if (pn == 7) unsafeAtomicAdd(ssq_kv + row, s0); else { unsafeAtomicAdd(ssq_q + row, s0); if (pn == 6) unsafeAtomicAdd(ssq_kv + row, s1); } } }
        } else {
            const int ct = (pn - 8) * 256;
#pragma unroll
            for (int ai = 0; ai < 2; ++ai)
#pragma unroll
                for (int m = 0; m < 4; ++m) { bf16* rowp = SG + (size_t)(row0 + ai * 128 + m * 16) * 2048 + ct + cw;
#pragma unroll
                    for (int bj = 0; bj < 2; ++bj) { f32x4 a = acc[ai][bj][m][0], b = acc[ai][bj][m][1];
#pragma unroll
                        for (int e = 0; e < 4; ++e) { a[e] = fsigmoid(a[e]); b[e] = fsigmoid(b[e]); }
                        *(u32x4*)(rowp + bj * 128) = pack8(a, b); } }
        }
    }
};
struct EpiQ {
    static constexpr bool PERM = true;
    bf16* Q; const float* ssq; const float *cosT, *sinT;
    __device__ __forceinline__ void operator()(f32x4 (&acc)[2][2][4][2], const Unit& u, int wr, int wc) const {
        int z_; asm volatile("v_mov_b32 %0, 0" : "=v"(z_)); const int lane_ = __builtin_amdgcn_mbcnt_hi(~0u, __builtin_amdgcn_mbcnt_lo(~0u, z_)), fr = lane_ & 15, fq = lane_ >> 4;
        const int row0 = u.pm * 256 + wr * 64 + fr, pn = u.pn, cw = wc * 32 + 8 * fq;
#pragma unroll
        for (int ai = 0; ai < 2; ++ai)
#pragma unroll
            for (int m = 0; m < 4; ++m) { const int row = row0 + ai * 128 + m * 16; const float rs = rsqrtf(ssq[row] * (1.f / QL) + EPS) * QSCALE; bf16* rowp = Q + (size_t)row * 1536 + pn * 256 + cw;
#pragma unroll
                for (int bj = 0; bj < 2; ++bj) { f32x4 v0 = acc[ai][bj][m][0] * rs, v1 = acc[ai][bj][m][1] * rs;
                    if ((8 * pn + 4 * bj + wc) % 3 == 2) rope8(v0, v1, cosT, sinT, row, fq);
                    *(u32x4*)(rowp + bj * 128) = pack8(v0, v1); }
                asm volatile("" ::: "memory"); }
    }
};
struct EpiKV {
    static constexpr bool PERM = true;
    bf16 *KN, *V; const float* ssq;
    __device__ __forceinline__ void operator()(f32x4 (&acc)[2][2][4][2], const Unit& u, int wr, int wc) const {
        int z_; asm volatile("v_mov_b32 %0, 0" : "=v"(z_)); const int lane_ = __builtin_amdgcn_mbcnt_hi(~0u, __builtin_amdgcn_mbcnt_lo(~0u, z_)), fr = lane_ & 15, fq = lane_ >> 4;
        const int row0 = u.pm * 256 + wr * 64 + fr, pn = u.pn, cw = wc * 32 + 8 * fq; bf16* base = (pn < 4) ? KN : V; const int ct = (pn & 3) * 256;
#pragma unroll
        for (int ai = 0; ai < 2; ++ai)
#pragma unroll
            for (int m = 0; m < 4; ++m) { const int row = row0 + ai * 128 + m * 16; const float rs = rsqrtf(ssq[row] * (1.f / KVL) + EPS); bf16* rowp = base + (size_t)row * 1024 + ct + cw;
#pragma unroll
                for (int bj = 0; bj < 2; ++bj) *(u32x4*)(rowp + bj * 128) = pack8(acc[ai][bj][m][0] * rs, acc[ai][bj][m][1] * rs);
                asm volatile("" ::: "memory"); }
    }
};
template <bool SECOND> struct EpiMerge {
    static constexpr bool PERM = true;
    bf16* MG; const bf16* SG; int sgoff;
    __device__ __forceinline__ void operator()(f32x4 (&acc)[2][2][4][2], const Unit& u, int wr, int wc) const {
        int z_; asm volatile("v_mov_b32 %0, 0" : "=v"(z_)); const int lane_ = __builtin_amdgcn_mbcnt_hi(~0u, __builtin_amdgcn_mbcnt_lo(~0u, z_)), fr = lane_ & 15, fq = lane_ >> 4;
        const int row0 = u.pm * 256 + wr * 64 + fr, col0 = u.pn * 256 + wc * 32 + 8 * fq;
#pragma unroll
        for (int ai = 0; ai < 2; ++ai)
#pragma unroll
            for (int m = 0; m < 4; ++m) { const int row = row0 + ai * 128 + m * 16; bf16* rowp = MG + (size_t)row * 1024 + col0; const bf16* sgp = SG + (size_t)row * 2048 + sgoff + col0;
#pragma unroll
                for (int bj = 0; bj < 2; ++bj) { const u32x4 g = *(const u32x4*)(sgp + bj * 128); f32x4 v0 = acc[ai][bj][m][0], v1 = acc[ai][bj][m][1];
                    v0[0] *= bflo(g.x); v0[1] *= bfhi(g.x); v0[2] *= bflo(g.y); v0[3] *= bfhi(g.y); v1[0] *= bflo(g.z); v1[1] *= bfhi(g.z); v1[2] *= bflo(g.w); v1[3] *= bfhi(g.w);
                    if (SECOND) { const u32x4 p = *(const u32x4*)(rowp + bj * 128);
                        v0[0] += bflo(p.x); v0[1] += bfhi(p.x); v0[2] += bflo(p.y); v0[3] += bfhi(p.y); v1[0] += bflo(p.z); v1[1] += bfhi(p.z); v1[2] += bflo(p.w); v1[3] += bfhi(p.w); }
                    *(u32x4*)(rowp + bj * 128) = pack8(v0, v1); } }
    }
};
struct EpiRes {
    static constexpr bool PERM = false;
    const float* base; float* out; const float* mod; int goff;
    __device__ __forceinline__ void operator()(f32x4 (&acc)[2][2][4][2], const Unit& u, int wr, int wc) const {
        int z_; asm volatile("v_mov_b32 %0, 0" : "=v"(z_)); const int lane_ = __builtin_amdgcn_mbcnt_hi(~0u, __builtin_amdgcn_mbcnt_lo(~0u, z_)), fr = lane_ & 15, fq = lane_ >> 4;
        const int row0 = u.pm * 256 + wr * 64 + fr, col0 = u.pn * 256 + wc * 32 + 4 * fq; const float* gate = mod + (u.pm >> 4) * 6144 + goff;
#pragma unroll
        for (int bj = 0; bj < 2; ++bj)
#pragma unroll
            for (int n = 0; n < 2; ++n) { const int col = col0 + bj * 128 + n * 16; const f32x4 gv = *(const f32x4*)(gate + col);
#pragma unroll
                for (int ai = 0; ai < 2; ++ai)
#pragma unroll
                    for (int m = 0; m < 4; ++m) { const size_t off = (size_t)(row0 + ai * 128 + m * 16) * 1024 + col; *(f32x4*)(out + off) = *(const f32x4*)(base + off) + gv * acc[ai][bj][m][n]; } }
    }
};
template <int CTRL> __device__ __forceinline__ float dpp_mov(float old, float src) { return __builtin_bit_cast(float, __builtin_amdgcn_update_dpp(__builtin_bit_cast(int, old), __builtin_bit_cast(int, src), CTRL, 0xf, 0xf, false)); }
struct EpiUp {
    static constexpr bool PERM = true;
    bf16* ACT; float* SIDE; const float *cw, *cb;
    __device__ __forceinline__ void operator()(f32x4 (&acc)[2][2][4][2], const Unit& u, int wr, int wc) const {
        int z_; asm volatile("v_mov_b32 %0, 0" : "=v"(z_)); const int lane_ = __builtin_amdgcn_mbcnt_hi(~0u, __builtin_amdgcn_mbcnt_lo(~0u, z_)), fr = lane_ & 15, fq = lane_ >> 4;
        const int row0 = u.pm * 256 + wr * 64 + fr, pn = u.pn, cwo = wc * 32 + 8 * fq;
        if (fr < 2 || fr >= 14) {
#pragma unroll
            for (int ai = 0; ai < 2; ++ai) { const int grp = (u.pm * 256 + ai * 128 + wr * 64) >> 6; const int m = (fr < 2) ? 0 : 3; const int slot = (fr < 2) ? fr : fr - 12;
                float* sp = SIDE + ((size_t)grp * 4 + slot) * NUP + pn * 256 + cwo;
#pragma unroll
                for (int bj = 0; bj < 2; ++bj)
#pragma unroll
                    for (int n = 0; n < 2; ++n) { const f32x4 v = (m == 0) ? acc[ai][bj][0][n] : acc[ai][bj][3][n]; *(f32x4*)(sp + bj * 128 + 4 * n) = v; } }
        }
#pragma unroll
        for (int n = 0; n < 2; ++n) {
            const int f0 = pn * 128 + cwo + 4 * n;
            f32x4 wg[3], wv[3];
#pragma unroll
            for (int k = 0; k < 3; ++k) { wg[k] = *(const f32x4*)(cw + k * NUP + f0); wv[k] = *(const f32x4*)(cw + k * NUP + DFF + f0); }
            const f32x4 bg = *(const f32x4*)(cb + f0), bv = *(const f32x4*)(cb + DFF + f0);
#pragma unroll
            for (int ai = 0; ai < 2; ++ai) {
                f32x4 pg = (f32x4){0.f, 0.f, 0.f, 0.f}, pv = pg;
#pragma unroll
                for (int m = 0; m < 4; ++m) { const f32x4 g = acc[ai][0][m][n], v = acc[ai][1][m][n]; f32x4 ug, uv;
#pragma unroll
                    for (int e = 0; e < 4; ++e) {
                        const float g1 = dpp_mov<0x111>(dpp_mov<0x121>(0.f, pg[e]), g[e]), g2 = dpp_mov<0x112>(dpp_mov<0x122>(0.f, pg[e]), g[e]);
                        const float v1 = dpp_mov<0x111>(dpp_mov<0x121>(0.f, pv[e]), v[e]), v2 = dpp_mov<0x112>(dpp_mov<0x122>(0.f, pv[e]), v[e]);
                        ug[e] = bg[e] + wg[2][e] * g[e] + wg[1][e] * g1 + wg[0][e] * g2; uv[e] = bv[e] + wv[2][e] * v[e] + wv[1][e] * v1 + wv[0][e] * v2; }
                    f32x4 o;
#pragma unroll
                    for (int e = 0; e < 4; ++e) o[e] = ug[e] * fsigmoid(ug[e]) * uv[e];
                    u32x2 w; w.x = cvt_pk_bf16(o[0], o[1]); w.y = cvt_pk_bf16(o[2], o[3]);
                    *(u32x2*)(ACT + (size_t)(row0 + ai * 128 + m * 16) * DFF + f0) = w;
                    pg = g; pv = v; }
            }
        }
    }
};
constexpr int NWAVES = 8;
constexpr int RING_OFF = 0, RING_BYTES = 131072;
constexpr int LDSCTL_OFF = RING_BYTES, MISC_OFF = LDSCTL_OFF + 320;
constexpr int LDS_BYTES = 147456;
struct Args { const float* in[27]; float* out; unsigned char* ws; int ph_lo, ph_hi; };
typedef const __attribute__((address_space(4))) Args* KArgs;
struct Frame {
    LAS unsigned char* lds; volatile LAS unsigned* MISC; unsigned char* ws; KArgs ka;
    int wave, vcu, G;
    float* out;
};
#define INP(i) (F.ka->in[i])
__device__ __forceinline__ int lane_id() { int z; asm volatile("v_mov_b32 %0, 0" : "=v"(z)); return __builtin_amdgcn_mbcnt_hi(~0u, __builtin_amdgcn_mbcnt_lo(~0u, z)); }

__device__ __forceinline__ void p0_transpose_item(const float* W, int K, int N, bf16* WT, int kb, int dst_row0, int src0, bool ilv, const float* kscale, LAS float* scr, int lane) {
    const int k0 = 64 * kb; const int sc = lane & 31; const int dn = ilv ? (2 * (sc & 15) + (sc >> 4)) : sc;
#pragma unroll 8
    for (int i = 0; i < 32; ++i) { const int kk = 2 * i + (lane >> 5); float v = W[(size_t)(k0 + kk) * N + src0 + sc]; if (kscale) v *= kscale[k0 + kk]; scr[kk * 33 + dn] = v; }
    LDS_WAIT(); asm volatile("" ::: "memory");
    const int c = lane & 7;
#pragma unroll
    for (int j = 0; j < 4; ++j) { const int n = (lane >> 3) + 8 * j; const LAS float* s = scr + (8 * c) * 33 + n;
        u32x4 o; o.x = cvt_pk_bf16(s[0 * 33], s[1 * 33]); o.y = cvt_pk_bf16(s[2 * 33], s[3 * 33]); o.z = cvt_pk_bf16(s[4 * 33], s[5 * 33]); o.w = cvt_pk_bf16(s[6 * 33], s[7 * 33]);
        *(u32x4*)(WT + (size_t)(dst_row0 + n) * K + k0 + 8 * c) = o; }
    LDS_WAIT(); asm volatile("" ::: "memory");
}
__device__ __forceinline__ void p0_prologue(Frame& F) {
    LAS float* scr = (LAS float*)(F.lds + RING_OFF + F.wave * 16384); const int lane = lane_id();
    const int gw = F.vcu * NWAVES + F.wave, NGW = F.G * NWAVES;
    constexpr int I_IN = 16 * 128, I_UQ = 6 * 48, I_UKV = 4 * 64, I_PR = 20 * 32, I_PM = 16 * 32, I_OUT = 16 * 32, I_UP = 16 * 176, I_DN = 44 * 32;
    constexpr int NITEMS = I_IN + I_UQ + I_UKV + I_PR + I_PM + I_OUT + I_UP + I_DN;
    for (int it = gw; it < NITEMS; it += NGW) {
        int r = it;
        if (r < I_IN) { const int nb = r % 128, kb = r / 128; if (nb >= 61 && nb < 64) continue; const int src0 = nb < 61 ? 32 * nb : 1952 + 32 * (nb - 64);
            p0_transpose_item(INP(6), DM, DIN, (bf16*)(F.ws + WS_WIN), kb, 32 * nb, src0, nb == 60, nullptr, scr, lane); continue; } r -= I_IN;
        if (r < I_UQ) { const int nb = r % 48, kb = r / 48; p0_transpose_item(INP(15), QL, 1536, (bf16*)(F.ws + WS_WUQ), kb, 32 * nb, 32 * nb, (nb % 3) == 2, INP(14), scr, lane); continue; } r -= I_UQ;
        if (r < I_UKV) { const int nb = r % 64, kb = r / 64; const int nb2 = nb & 31, hh = nb2 >> 1, half = nb2 & 1; const int src0 = 128 * hh + (nb >= 32 ? 64 : 0) + 32 * half;
            p0_transpose_item(INP(17), KVL, 2048, (bf16*)(F.ws + WS_WUKV), kb, 32 * nb, src0, false, INP(16), scr, lane); continue; } r -= I_UKV;
        if (r < I_PR) { const int nb = r % 32, kb = r / 32; p0_transpose_item(INP(18), DRNN, DM, (bf16*)(F.ws + WS_WPR), kb, 32 * nb, 32 * nb, false, nullptr, scr, lane); continue; } r -= I_PR;
        if (r < I_PM) { const int nb = r % 32, kb = r / 32; p0_transpose_item(INP(19), DM, DM, (bf16*)(F.ws + WS_WPM), kb, 32 * nb, 32 * nb, false, nullptr, scr, lane); continue; } r -= I_PM;
        if (r < I_OUT) { const int nb = r % 32, kb = r / 32; p0_transpose_item(INP(20), DM, DM, (bf16*)(F.ws + WS_WOUT), kb, 32 * nb, 32 * nb, false, nullptr, scr, lane); continue; } r -= I_OUT;
        if (r < I_UP) { const int nb = r % 176, kb = r / 176; const int j = nb >> 3, w = nb & 7; const int src0 = (w < 4) ? 128 * j + 32 * w : DFF + 128 * j + 32 * (w - 4);
            p0_transpose_item(INP(22), DM, NUP, (bf16*)(F.ws + WS_WUP), kb, 32 * nb, src0, false, nullptr, scr, lane); continue; } r -= I_UP;
        { const int nb = r % 32, kb = r / 32; p0_transpose_item(INP(25), DFF, DM, (bf16*)(F.ws + WS_WDN), kb, 32 * nb, 32 * nb, false, nullptr, scr, lane); }
    }
    float* mod = (float*)(F.ws + WS_CTL + CTL_MOD);
    for (int it = gw; it < 96 * 16; it += NGW) { const int cc = it % 96, ks = it / 96, col = cc * 64 + lane, k0 = ks * 64;
#pragma unroll
        for (int b = 0; b < 8; ++b) { const float cv = INP(1)[b * DM + k0 + lane]; scr[b * 64 + lane] = cv * fsigmoid(cv); }
        LDS_WAIT(); asm volatile("" ::: "memory");
        float a[8];
#pragma unroll
        for (int b = 0; b < 8; ++b) a[b] = (ks == 0) ? INP(4)[col] : 0.f;
#pragma unroll 8
        for (int k = 0; k < 64; ++k) { const float w = INP(3)[(size_t)(k0 + k) * 6144 + col];
#pragma unroll
            for (int b = 0; b < 8; ++b) a[b] += scr[b * 64 + k] * w; }
#pragma unroll
        for (int b = 0; b < 8; ++b) unsafeAtomicAdd(mod + b * 6144 + col, a[b]);
        LDS_WAIT(); asm volatile("" ::: "memory");
    }
    float* cosT = (float*)(F.ws + WS_COS); float* sinT = (float*)(F.ws + WS_SIN); const int* pos = (const int*)INP(2);
    for (int i = F.vcu * 512 + F.wave * 64 + lane; i < NT * 16; i += F.G * 512) { const int t = i >> 4, j = i & 15;
        const float inv = powf(10000.f, -(float)j / 16.f); const float ang = (float)pos[t] * inv;
        cosT[i] = cosf(ang); sinT[i] = sinf(ang); }
}

__device__ __forceinline__ void norm_rows_mod(Frame& F, const float* src, bf16* dst, const float* g, int soff, int hoff) {
    const int lane = lane_id(); const int gw = F.vcu * NWAVES + F.wave, NGW = F.G * NWAVES; const float* mod = (const float*)(F.ws + WS_CTL + CTL_MOD);
    for (int rb = gw; rb < NT / 16; rb += NGW) { const int b = rb >> 8; const float* mb = mod + b * 6144;
        f32x4 gg[4], sh[4];
#pragma unroll
        for (int j = 0; j < 4; ++j) { const int col = 4 * lane + 256 * j; const f32x4 gv = *(const f32x4*)(g + col), sc = *(const f32x4*)(mb + soff + col); gg[j] = gv * (sc + 1.0f); sh[j] = *(const f32x4*)(mb + hoff + col); }
        for (int r = 0; r < 16; ++r) { const size_t row = (size_t)rb * 16 + r; const f32x4* xr = (const f32x4*)(src + row * DM) + lane;
            f32x4 v[4]; float s = 0.f;
#pragma unroll
            for (int j = 0; j < 4; ++j) { v[j] = xr[64 * j]; s += sumsq4(v[j]); }
            const float rinv = rsqrtf(wave_sum(s) * (1.f / DM) + EPS);
            u32x2* o8 = (u32x2*)(dst + row * DM) + lane;
#pragma unroll
            for (int j = 0; j < 4; ++j) { const f32x4 y = v[j] * rinv * gg[j] + sh[j]; u32x2 w; w.x = cvt_pk_bf16(y[0], y[1]); w.y = cvt_pk_bf16(y[2], y[3]); o8[64 * j] = w; } }
    }
}
__device__ __forceinline__ void norm_rows_final(Frame& F, float* io, const float* g) {
    const int lane = lane_id(); const int gw = F.vcu * NWAVES + F.wave, NGW = F.G * NWAVES;
    f32x4 gg[4];
#pragma unroll
    for (int j = 0; j < 4; ++j) gg[j] = *(const f32x4*)(g + 4 * lane + 256 * j);
    for (int row = gw; row < NT; row += NGW) { f32x4* xr = (f32x4*)(io + (size_t)row * DM) + lane;
        f32x4 v[4]; float s = 0.f;
#pragma unroll
        for (int j = 0; j < 4; ++j) { v[j] = xr[64 * j]; s += sumsq4(v[j]); }
        const float rinv = rsqrtf(wave_sum(s) * (1.f / DM) + EPS);
#pragma unroll
        for (int j = 0; j < 4; ++j) xr[64 * j] = v[j] * rinv * gg[j]; }
}
__device__ __forceinline__ void ffn_fixup(Frame& F, bf16* ACT, const float* SIDE, const float* cw, const float* cb) {
    const int lane = lane_id(); const int gw = F.vcu * NWAVES + F.wave, NGW = F.G * NWAVES;
    for (int it = gw; it < 512 * 22; it += NGW) { const int grp = it / 22, j = it % 22, rs = lane >> 5, l = lane & 31, f0 = 128 * j + 4 * l;
        const float* s0 = SIDE + ((size_t)grp * 4) * NUP + 256 * j + 4 * l; const float* sp = s0 - (size_t)4 * NUP;
        const bool first = (grp & 63) == 0;
        const f32x4 z = (f32x4){0.f, 0.f, 0.f, 0.f};
        f32x4 cur[2], p1[2], p2[2];
#pragma unroll
        for (int h = 0; h < 2; ++h) { const int co = 128 * h;
            const f32x4 r0 = *(const f32x4*)(s0 + co), r1 = *(const f32x4*)(s0 + NUP + co);
            const f32x4 q63 = first ? z : *(const f32x4*)(sp + 3 * (size_t)NUP + co), q62 = first ? z : *(const f32x4*)(sp + 2 * (size_t)NUP + co);
            cur[h] = rs ? r1 : r0; p1[h] = rs ? r0 : q63; p2[h] = rs ? q63 : q62; }
        f32x4 u[2];
#pragma unroll
        for (int h = 0; h < 2; ++h) { const int fo = h * DFF + f0; u[h] = *(const f32x4*)(cb + fo) + *(const f32x4*)(cw + 2 * NUP + fo) * cur[h] + *(const f32x4*)(cw + NUP + fo) * p1[h] + *(const f32x4*)(cw + fo) * p2[h]; }
        f32x4 o;
#pragma unroll
        for (int e = 0; e < 4; ++e) o[e] = u[0][e] * fsigmoid(u[0][e]) * u[1][e];
        u32x2 w; w.x = cvt_pk_bf16(o[0], o[1]); w.y = cvt_pk_bf16(o[2], o[3]);
        *(u32x2*)(ACT + ((size_t)grp * 64 + rs) * DFF + f0) = w; }
}
__device__ __forceinline__ int crow(int r, int hi) { return (r & 3) + 8 * (r >> 2) + 4 * hi; }
namespace rnn {
constexpr int L_WG = 0, L_CW = 18432, L_CB = L_CW + 1024, L_TOT = L_CB + 256, L_IN = L_TOT + 8192, IN_BYTES = 5120, L_OUT = L_IN + NWAVES * IN_BYTES, L_END = L_OUT + NWAVES * 4096;
static_assert(L_END <= RING_BYTES, "rnn LDS");
__device__ __forceinline__ void unit(Frame& F, int b, int n) {
    LAS unsigned char* L = F.lds; const int lane = lane_id(), wid = F.wave, tid = wid * 64 + lane, r32 = lane & 31, hi = lane >> 5;
    const bf16* XR = (const bf16*)(F.ws + WS_R2); bf16* YR = (bf16*)(F.ws + WS_R1); const int* pos = (const int*)INP(2) + b * SEQ;
    __syncthreads();
    { const float* wa = INP(9) + n * 4096; const float* wx = INP(11) + n * 4096; LAS bf16* wg = (LAS bf16*)(L + L_WG);
      for (int i = tid; i < 4096; i += 512) { const int d = i >> 6, e = i & 63; wg[e * 72 + d] = (bf16)(cvt_pk_bf16(wa[i], 0.f) & 0xffffu); wg[(64 + e) * 72 + d] = (bf16)(cvt_pk_bf16(wx[i], 0.f) & 0xffffu); }
      if (tid < 256) ((LAS float*)(L + L_CW))[tid] = INP(7)[(tid >> 6) * DRNN + 64 * n + (tid & 63)];
      if (tid < 64) ((LAS float*)(L + L_CB))[tid] = INP(8)[64 * n + tid]; }
    __syncthreads();
    const LAS unsigned char* wgL = L + L_WG + (r32 * 72 + 8 * hi) * 2;
    float cba[2], cbx[2], ckc[2], carry[2];
#pragma unroll
    for (int nt = 0; nt < 2; ++nt) { const int ch = 64 * n + 32 * nt + r32; cba[nt] = -LOG2E * INP(10)[ch]; cbx[nt] = -LOG2E * INP(12)[ch]; const float Lp = INP(13)[ch]; ckc[nt] = -8.f * ((-Lp > 20.f) ? -Lp : log1pf(expf(-Lp))); carry[nt] = 0.f; }
    const LAS float* cwL = (const LAS float*)(L + L_CW); const LAS float* cbL = (const LAS float*)(L + L_CB);
    LAS unsigned char* inT = L + L_IN + wid * IN_BYTES; LAS unsigned char* outT = L + L_OUT + wid * 4096;
    u32x4 pre[5];
#define RNN_LOAD(chunk_) do { const int t0_ = (chunk_) * 256 + wid * 32 - 3; \
        _Pragma("unroll") for (int i = 0; i < 5; ++i) { const int p = lane + 64 * i, j = p >> 3, c = p & 7; const int tt = t0_ + j; const int ttc = tt < 0 ? 0 : tt; \
            pre[i] = (u32x4){0u, 0u, 0u, 0u}; if (p < 280 && tt >= 0) pre[i] = *(const u32x4*)(XR + (size_t)(b * SEQ + ttc) * DRNN + 64 * n + 8 * c); } } while (0)
    RNN_LOAD(0);
    for (int chunk = 0; chunk < 16; ++chunk) {
        const int lane = lane_id(), r32 = lane & 31, hi = lane >> 5;
        const LAS unsigned char* wgL = L + L_WG + (r32 * 72 + 8 * hi) * 2;
        const int tok0 = chunk * 256 + wid * 32, tA = tok0 + r32;
        const unsigned long long rmask = __ballot(pos[tA] == 0);
#pragma unroll
        for (int i = 0; i < 5; ++i) { const int p = lane + 64 * i; if (p < 280) *(LAS u32x4*)(inT + (p >> 3) * 144 + (p & 7) * 16) = pre[i]; }
        LDS_WAIT();
        bf16x8 A[4];
#pragma unroll
        for (int kk = 0; kk < 4; ++kk) { const int c0 = 16 * kk + 8 * hi;
            f32x4 a0 = *(const LAS f32x4*)(cbL + c0), a1 = *(const LAS f32x4*)(cbL + c0 + 4);
#pragma unroll
            for (int tap = 0; tap < 4; ++tap) { const u32x4 xv = *(const LAS u32x4*)(inT + (r32 + tap) * 144 + c0 * 2);
                const f32x4 w0 = *(const LAS f32x4*)(cwL + tap * 64 + c0), w1 = *(const LAS f32x4*)(cwL + tap * 64 + c0 + 4);
                a0[0] += w0[0] * bflo(xv.x); a0[1] += w0[1] * bfhi(xv.x); a0[2] += w0[2] * bflo(xv.y); a0[3] += w0[3] * bfhi(xv.y);
                a1[0] += w1[0] * bflo(xv.z); a1[1] += w1[1] * bfhi(xv.z); a1[2] += w1[2] * bflo(xv.w); a1[3] += w1[3] * bfhi(xv.w); }
            A[kk] = __builtin_bit_cast(bf16x8, pack8(a0, a1)); asm volatile("" ::: "memory"); }
        LAS float* tot = (LAS float*)(L + L_TOT) + (chunk & 1) * 1024;
#pragma unroll
        for (int nt = 0; nt < 2; ++nt) {
            float aa[16], bb[16], As[8], Bs[8];
            f32x16 za = {}, zx = {}, xc = {};
#pragma unroll
            for (int kk = 0; kk < 4; ++kk) {
                const int dd = 32 * nt + r32 - 16 * kk - 8 * hi; u32x4 iw;
                iw.x = dd == 0 ? 0x3F80u : dd == 1 ? 0x3F800000u : 0u; iw.y = dd == 2 ? 0x3F80u : dd == 3 ? 0x3F800000u : 0u; iw.z = dd == 4 ? 0x3F80u : dd == 5 ? 0x3F800000u : 0u; iw.w = dd == 6 ? 0x3F80u : dd == 7 ? 0x3F800000u : 0u;
                const bf16x8 fa = *(const LAS bf16x8*)(wgL + (32 * nt * 72 + 16 * kk) * 2), fx = *(const LAS bf16x8*)(wgL + ((64 + 32 * nt) * 72 + 16 * kk) * 2);
                za = __builtin_amdgcn_mfma_f32_32x32x16_bf16(A[kk], fa, za, 0, 0, 0);
                zx = __builtin_amdgcn_mfma_f32_32x32x16_bf16(A[kk], fx, zx, 0, 0, 0);
                xc = __builtin_amdgcn_mfma_f32_32x32x16_bf16(A[kk], __builtin_bit_cast(bf16x8, iw), xc, 0, 0, 0); }
            const float kc = ckc[nt], kc2 = 2.f * kc, kcl = LOG2E * kc;
#define RNN_ELEMS(RST) _Pragma("unroll") for (int r = 0; r < 16; ++r) { \
                const float rg = __builtin_amdgcn_rcpf(1.f + __builtin_amdgcn_exp2f(za[r] * -LOG2E + cba[nt])), ig = __builtin_amdgcn_rcpf(1.f + __builtin_amdgcn_exp2f(zx[r] * -LOG2E + cbx[nt])); \
                float a = __builtin_amdgcn_exp2f(kcl * rg);                                                   \
                const float x2 = kc2 * rg; const float ser = -x2 * (1.f + x2 * (0.5f + x2 * (0.16666667f + x2 * (0.041666668f + x2 * (0.0083333338f + x2 * 0.0013888889f))))); \
                const float em = (x2 > -0.25f) ? ser : (1.f - a * a);                                        \
                float mult = __builtin_amdgcn_sqrtf(em); \
                if (RST) { if ((rmask >> crow(r, hi)) & 1ull) { a = 0.f; mult = 1.f; } }                      \
                aa[r] = a; bb[r] = mult * (ig * xc[r]); }
            if (rmask == 0ull) { RNN_ELEMS(false) } else { RNN_ELEMS(true) }
#undef RNN_ELEMS
#pragma unroll
            for (int g = 0; g < 4; ++g) { const float a0 = aa[4 * g], a1 = aa[4 * g + 1], a2 = aa[4 * g + 2], a3 = aa[4 * g + 3];
                const float Ag = (a0 * a1) * (a2 * a3), Bg = ((bb[4 * g] * a1 + bb[4 * g + 1]) * a2 + bb[4 * g + 2]) * a3 + bb[4 * g + 3];
                const float Ao = __shfl_xor(Ag, 32), Bo = __shfl_xor(Bg, 32);
                As[2 * g] = hi ? Ao : Ag; Bs[2 * g] = hi ? Bo : Bg; As[2 * g + 1] = hi ? Ag : Ao; Bs[2 * g + 1] = hi ? Bg : Bo; }
            float At = 1.f, Bt = 0.f;
#pragma unroll
            for (int s = 0; s < 8; ++s) { Bt = As[s] * Bt + Bs[s]; At *= As[s]; }
            if (hi == 0) *(LAS f32x2*)(tot + ((wid * 2 + nt) * 32 + r32) * 2) = (f32x2){At, Bt};
            if (nt == 1 && chunk + 1 < 16) RNN_LOAD(chunk + 1);
            __syncthreads();
            float hin = carry[nt], hh = carry[nt];
#pragma unroll
            for (int j = 0; j < 8; ++j) { const f32x2 ab = *(const LAS f32x2*)(tot + ((j * 2 + nt) * 32 + r32) * 2); if (j == wid) hin = hh; hh = ab.x * hh + ab.y; }
            carry[nt] = hh;
            float hseg[4]; float h = hin;
#pragma unroll
            for (int s = 0; s < 8; ++s) { if ((s & 1) == hi) hseg[s >> 1] = h; h = As[s] * h + Bs[s]; }
#pragma unroll
            for (int g = 0; g < 4; ++g) { float hv = hseg[g];
#pragma unroll
                for (int q = 0; q < 4; ++q) { const int r = 4 * g + q; hv = aa[r] * hv + bb[r];
                    *(LAS bf16*)(outT + crow(r, hi) * 128 + (32 * nt + r32) * 2) = (bf16)(cvt_pk_bf16(hv, 0.f) & 0xffffu); } }
        }
        LDS_WAIT();
#pragma unroll
        for (int i = 0; i < 4; ++i) { const int p = lane + 64 * i, row = p >> 3, c = p & 7; const u32x4 v = *(const LAS u32x4*)(outT + row * 128 + c * 16);
            *(u32x4*)(YR + (size_t)(b * SEQ + tok0 + row) * DRNN + 64 * n + 8 * c) = v; }
    }
#undef RNN_LOAD
}
}

namespace att {
constexpr int KSLOT = 12288, VSLOT = 8192, NKS = 3, NVS = 4;
constexpr int L_K = 0, L_V = NKS * KSLOT, L_WS = L_V + NVS * VSLOT, L_OST = L_WS + NWAVES * 256, L_END = L_OST + NWAVES * 4096;
static_assert(L_END <= RING_BYTES, "attention LDS");
__device__ __forceinline__ void glds16(const void* gsrc, unsigned lds_dst) { unsigned keep;
    asm volatile("s_mov_b32 %0, m0\n\ts_mov_b32 m0, %2\n\ts_nop 0\n\tglobal_load_lds_dwordx4 %1, off\n\ts_mov_b32 m0, %0" : "=&s"(keep) : "v"(gsrc), "s"(lds_dst) : "memory"); }
#define ATT_WAIT_BAR(N) asm volatile("s_waitcnt vmcnt(" #N ") lgkmcnt(0)\n\ts_barrier" ::: "memory")
__device__ __forceinline__ float max3f(float a, float b, float c) { return __builtin_fmaxf(__builtin_fmaxf(a, b), c); }
__device__ __forceinline__ void unit(Frame& F, int b, int h, int qb) {
    LAS unsigned char* shm = F.lds; const int lane = lane_id(), wid = F.wave, r32 = lane & 31, hi = lane >> 5;
    const bf16* Q = (const bf16*)(F.ws + WS_Q); const bf16* KN = (const bf16*)(F.ws + WS_KN); const bf16* KR = (const bf16*)(F.ws + WS_KR); const bf16* V = (const bf16*)(F.ws + WS_V); bf16* O = (bf16*)(F.ws + WS_R2);
    const long rowbase = (long)b * SEQ; const int q0 = qb * 256;
    const bf16* Qw = Q + (rowbase + q0 + wid * 32) * 1536 + h * 96;
    const bf16* ksrc = KN + (rowbase + lane) * 1024 + h * 64 + wid * 8;
    const bf16* rsrc = KR + (rowbase + lane) * 32 + (wid & 3) * 8;
    const bf16* vsrc = V + (rowbase + 16 * (wid & 3) + (lane >> 2)) * 1024 + h * 64 + (wid >> 2) * 32 + (lane & 3) * 8;
    const unsigned lds0 = (unsigned)(size_t)shm;
    const unsigned kdst = lds0 + L_K + wid * 1024, rdst = lds0 + L_K + (8 + (wid & 3)) * 1024, vdst = lds0 + L_V + wid * 1024;
#define ATT_DMA(t, ks, vs) do { glds16(ksrc + (long)(t) * 65536, (unsigned)__builtin_amdgcn_readfirstlane(kdst + (ks) * KSLOT)); glds16(rsrc + (long)(t) * 2048, (unsigned)__builtin_amdgcn_readfirstlane(rdst + (ks) * KSLOT)); \
        glds16(vsrc + (long)(t) * 65536, (unsigned)__builtin_amdgcn_readfirstlane(vdst + (vs) * VSLOT)); } while (0)
    const int NTL = 4 * (qb + 1);
    ATT_DMA(0, 0, 0); ATT_DMA(1, 1, 1);
    bf16x8 qr[6];
#pragma unroll
    for (int d0 = 0; d0 < 6; ++d0) qr[d0] = *(const bf16x8*)(Qw + (long)r32 * 1536 + d0 * 16 + hi * 8);
    LAS float* wsf = (LAS float*)(shm + L_WS) + wid * 64;
    float mhat = 0.f, lsum = 0.f; f32x16 o[2]; o[0] = f32x16{}; o[1] = f32x16{}; f32x16 negm = f32x16{};
    const int qrel = wid * 32 + r32;
    const bool grpB = wid >= 4;
    const int jskip = NTL - 4 + (wid >> 1) + 1;
    f32x16 p0, p1;
#define ATT_SMPV(tt, vs) do { \
        const int jb_ = (tt) - (NTL - 4); \
        if (jb_ >= 0) { const int kb0 = 64 * jb_ + 4 * hi; \
            _Pragma("unroll") for (int r = 0; r < 16; ++r) { const int kv = kb0 + (r & 3) + 8 * (r >> 2); if (kv > qrel) p0[r] = -INFINITY; if (kv + 32 > qrel) p1[r] = -INFINITY; } } \
        float ra = max3f(p0[0], p0[1], p1[0]), rb = max3f(p0[2], p0[3], p1[1]); ra = max3f(ra, p1[2], p1[3]); \
        _Pragma("unroll") for (int r = 4; r < 16; r += 4) { ra = max3f(ra, p0[r], p0[r + 1]); rb = max3f(rb, p0[r + 2], p0[r + 3]); ra = max3f(ra, p1[r], p1[r + 1]); rb = max3f(rb, p1[r + 2], p1[r + 3]); } \
        float rm = __builtin_fmaxf(ra, rb); { auto rr = __builtin_amdgcn_permlane32_swap(__float_as_uint(rm), __float_as_uint(rm), false, false); rm = __builtin_fmaxf(__uint_as_float(rr[0]), __uint_as_float(rr[1])); } \
        if ((tt) == 0 || __any(rm > 8.0f)) { const float dl = ((tt) == 0) ? rm : __builtin_fmaxf(rm, 0.f); mhat += dl; \
            _Pragma("unroll") for (int r = 0; r < 16; ++r) { p0[r] -= dl; p1[r] -= dl; negm[r] = -mhat; } \
            const float f = __builtin_amdgcn_exp2f(-dl); lsum *= f; if (hi == 0) wsf[r32] = f; LDS_WAIT(); \
            _Pragma("unroll") for (int r = 0; r < 16; ++r) { const float g = wsf[crow(r, hi)]; o[0][r] *= g; o[1][r] *= g; } } \
        float sacc = 0.f; \
        _Pragma("unroll") for (int r = 0; r < 16; ++r) { p0[r] = __builtin_amdgcn_exp2f(p0[r]); p1[r] = __builtin_amdgcn_exp2f(p1[r]); sacc += p0[r] + p1[r]; } \
        lsum += sacc; \
        u32x4 pw0, pw1, pw2, pw3; \
        pw0 = (u32x4){cvt_pk_bf16(p0[0], p0[1]), cvt_pk_bf16(p0[2], p0[3]), cvt_pk_bf16(p0[4], p0[5]), cvt_pk_bf16(p0[6], p0[7])}; pw1 = (u32x4){cvt_pk_bf16(p0[8], p0[9]), cvt_pk_bf16(p0[10], p0[11]), cvt_pk_bf16(p0[12], p0[13]), cvt_pk_bf16(p0[14], p0[15])}; \
        pw2 = (u32x4){cvt_pk_bf16(p1[0], p1[1]), cvt_pk_bf16(p1[2], p1[3]), cvt_pk_bf16(p1[4], p1[5]), cvt_pk_bf16(p1[6], p1[7])}; pw3 = (u32x4){cvt_pk_bf16(p1[8], p1[9]), cvt_pk_bf16(p1[10], p1[11]), cvt_pk_bf16(p1[12], p1[13]), cvt_pk_bf16(p1[14], p1[15])}; \
        const int vb = (int)(lds0 + L_V + (vs) * VSLOT) + ((lane >> 4) & 1) * 32 + (lane & 3) * 8 + (4 * hi + ((lane & 15) >> 2)) * 64; \
        _Pragma("unroll") for (int d0 = 0; d0 < 2; ++d0) { s16x4 lo[4], hi4[4]; \
            _Pragma("unroll") for (int ks = 0; ks < 4; ++ks) { \
                asm volatile("ds_read_b64_tr_b16 %0,%1 offset:%c2" : "=&v"(lo[ks]) : "v"(vb), "i"(d0 * 4096 + ks * 1024) : "memory"); \
                asm volatile("ds_read_b64_tr_b16 %0,%1 offset:%c2" : "=&v"(hi4[ks]) : "v"(vb), "i"(d0 * 4096 + ks * 1024 + 512) : "memory"); } \
            asm volatile("s_waitcnt lgkmcnt(0)" ::: "memory"); __builtin_amdgcn_sched_barrier(0); \
            o[d0] = __builtin_amdgcn_mfma_f32_32x32x16_bf16(__builtin_bit_cast(bf16x8, pw0), ATT_PK(0), o[d0], 0, 0, 0); \
            o[d0] = __builtin_amdgcn_mfma_f32_32x32x16_bf16(__builtin_bit_cast(bf16x8, pw1), ATT_PK(1), o[d0], 0, 0, 0); \
            o[d0] = __builtin_amdgcn_mfma_f32_32x32x16_bf16(__builtin_bit_cast(bf16x8, pw2), ATT_PK(2), o[d0], 0, 0, 0); \
            o[d0] = __builtin_amdgcn_mfma_f32_32x32x16_bf16(__builtin_bit_cast(bf16x8, pw3), ATT_PK(3), o[d0], 0, 0, 0); } \
    } while (0)
#define ATT_PK(k) (bf16x8){lo[k][0], lo[k][1], lo[k][2], lo[k][3], hi4[k][0], hi4[k][1], hi4[k][2], hi4[k][3]}
    int ks_cur = 0;
    for (int t = 0; t < NTL; ++t) {
        if (t + 1 < NTL) ATT_WAIT_BAR(3); else ATT_WAIT_BAR(0);
        if (t + 2 < NTL) { const int k2 = ks_cur >= 1 ? ks_cur - 1 : 2; ATT_DMA(t + 2, k2, (t + 2) & 3); }
        if (grpB && t > 0 && t - 1 < jskip) ATT_SMPV(t - 1, (t - 1) & 3);
        if (t < jskip) {
            const LAS unsigned char* kb = shm + L_K + ks_cur * KSLOT + hi * 1024 + r32 * 16;
            p0 = negm; p1 = negm;
#pragma unroll
            for (int d0 = 0; d0 < 6; ++d0) { const bf16x8 b0 = *(const LAS bf16x8*)(kb + d0 * 2048), b1 = *(const LAS bf16x8*)(kb + d0 * 2048 + 512);
                p0 = __builtin_amdgcn_mfma_f32_32x32x16_bf16(b0, qr[d0], p0, 0, 0, 0); p1 = __builtin_amdgcn_mfma_f32_32x32x16_bf16(b1, qr[d0], p1, 0, 0, 0); }
            if (!grpB) ATT_SMPV(t, t & 3);
        }
        ks_cur = ks_cur == 2 ? 0 : ks_cur + 1;
    }
    if (grpB && NTL - 1 < jskip) ATT_SMPV(NTL - 1, (NTL - 1) & 3);
#undef ATT_PK
#undef ATT_SMPV
    lsum += __shfl_xor(lsum, 32);
    if (hi == 0) wsf[32 + r32] = lsum; LDS_WAIT();
    float rli[16];
#pragma unroll
    for (int r = 0; r < 16; ++r) rli[r] = __builtin_amdgcn_rcpf(wsf[32 + crow(r, hi)]);
    bf16* Ow = O + (rowbase + q0 + wid * 32) * 1024 + h * 64;
    { LAS bf16* stg = (LAS bf16*)(shm + L_OST) + wid * 2048;
#pragma unroll
      for (int r = 0; r < 16; ++r) { const int orow = crow(r, hi);
#pragma unroll
          for (int d0 = 0; d0 < 2; ++d0) stg[orow * 64 + d0 * 32 + r32] = (bf16)(cvt_pk_bf16(o[d0][r] * rli[r], 0.f) & 0xffffu); }
      LDS_WAIT();
#pragma unroll
      for (int i = 0; i < 4; ++i) { const int row = i * 8 + (lane >> 3), ch = lane & 7; const u32x4 v = *(const LAS u32x4*)(stg + row * 64 + ch * 8); *(u32x4*)(Ow + (long)row * 1024 + ch * 8) = v; } }
    asm volatile("s_waitcnt lgkmcnt(0)\n\ts_barrier" ::: "memory");
#undef ATT_DMA
}
#undef ATT_WAIT_BAR
}
#ifdef DBG_STOP_AFTER
__global__ void dbg_dump_k(float* out, unsigned char* ws, int stage) {
    const size_t NOUT = (size_t)NT * 1024; const size_t nthr = (size_t)gridDim.x * blockDim.x;
    for (size_t j = (size_t)blockIdx.x * blockDim.x + threadIdx.x; j < NOUT; j += nthr) {
        float a = 0.f;
        auto addb = [&](const void* p, size_t n) { const bf16* q = (const bf16*)p; for (size_t i = j; i < n; i += NOUT) a += __uint_as_float((unsigned)q[i] << 16); };
        auto addf = [&](const void* p, size_t n) { const float* q = (const float*)p; for (size_t i = j; i < n; i += NOUT) a += q[i]; };
        if (stage == 0) { addb(ws + WS_WIN, (size_t)35 * MiB / 2); addf(ws + WS_COS, (size_t)NT * 16); addf(ws + WS_SIN, (size_t)NT * 16); addf(ws + WS_CTL + CTL_MOD, 8 * 6144); }
        else if (stage == 1) { addb(ws + WS_R1, (size_t)NT * 1024); }
        else if (stage == 2) { const unsigned w = ((const unsigned*)out)[j]; a = __uint_as_float(w << 16) + __uint_as_float(w & 0xffff0000u);
            addb(ws + WS_R2, (size_t)NT * 1280); addb(ws + WS_LAT, (size_t)NT * 768); addb(ws + WS_KR, (size_t)NT * 32); addf(ws + WS_CTL + CTL_SSQQ, NT); addf(ws + WS_CTL + CTL_SSQKV, NT); }
        else if (stage == 20) { const unsigned w = ((const unsigned*)out)[j]; a = __uint_as_float(w << 16) + __uint_as_float(w & 0xffff0000u); }
        else if (stage == 24) { addb(ws + WS_Q, (size_t)NT * 2048); }
        else if (stage == 21) { addb(ws + WS_R2, (size_t)NT * 1280); }
        else if (stage == 22) { addb(ws + WS_LAT, (size_t)NT * 768); addb(ws + WS_KR, (size_t)NT * 32); }
        else if (stage == 23) { addf(ws + WS_CTL + CTL_SSQQ, NT); addf(ws + WS_CTL + CTL_SSQKV, NT); }
        else if (stage == 3) { addb(ws + WS_R1, (size_t)NT * 1280); addb(ws + WS_Q, (size_t)NT * 1536); addb(ws + WS_KN, (size_t)NT * 1024); addb(ws + WS_V, (size_t)NT * 1024); }
        else if (stage == 4) { addb(ws + WS_R2, (size_t)NT * 1024); }
        else if (stage == 5) { addb(ws + WS_Q, (size_t)NT * 1024); }
        else if (stage == 7) { addb(ws + WS_R1, (size_t)NT * 1024); }
        else if (stage == 8) { addb(ws + WS_Q, (size_t)NT * 2816); addf(ws + WS_R2, (size_t)512 * 4 * 5632); }
        else if (stage == 9) { addb(ws + WS_Q, (size_t)NT * 2816); }
        else continue;
        out[j] = a;
    }
}
#endif
constexpr int N_PHASES = 12;
#ifndef MK_N_LAUNCHES
#define MK_N_LAUNCHES 1
#endif
__global__ void __launch_bounds__(NWAVES * 64, 2) mk_fwd(Args args) {
    extern __shared__ __attribute__((aligned(16))) unsigned char lds_raw[];
    Frame F;
    F.ka = (KArgs)__builtin_amdgcn_kernarg_segment_ptr();
    F.lds = (LAS unsigned char*)lds_raw; F.MISC = (volatile LAS unsigned*)(F.lds + MISC_OFF); F.ws = args.ws;
    F.wave = __builtin_amdgcn_readfirstlane(threadIdx.x >> 6);
    F.G = gridDim.x; { const int bx = blockIdx.x; F.vcu = (F.G % 8 == 0) ? (bx % 8) * (F.G / 8) + bx / 8 : bx; }
    F.out = args.out;
    for (int u = threadIdx.x; u < (LDS_BYTES - LDSCTL_OFF) / 4; u += NWAVES * 64) ((LAS unsigned*)(F.lds + LDSCTL_OFF))[u] = 0u;
    __syncthreads();
    unsigned char* ws = args.ws;
    XcdBarrier bar; bar.bar = (unsigned*)(ws + WS_CTL + CTL_BAR); bar.x = 0; bar.st = nullptr;
    if (MK_N_LAUNCHES == 1) bar = xcd_barrier_post((unsigned*)(ws + WS_CTL + CTL_BAR), F.MISC + 8);
    const int lo = args.ph_lo, hi = args.ph_hi;
#ifndef MK_PHASE_MASK
#define MK_PHASE_MASK 0xfff
#endif
#define IN(k) (((MK_PHASE_MASK >> (k)) & 1) && lo <= (k) && (k) < hi)
#ifndef DBG_REPEAT_PHASE
#define DBG_REPEAT_PHASE -1
#endif
#define NREP(k) ((k) == DBG_REPEAT_PHASE ? 2 : 1)
#define SEAM(k) do { if (IN(k) && IN((k) + 1)) xcd_barrier(bar); } while (0)
    bf16* WIN = (bf16*)(ws + WS_WIN); bf16* WUQ = (bf16*)(ws + WS_WUQ); bf16* WUKV = (bf16*)(ws + WS_WUKV); bf16* WPR = (bf16*)(ws + WS_WPR); bf16* WPM = (bf16*)(ws + WS_WPM);
    bf16* WOUT = (bf16*)(ws + WS_WOUT); bf16* WUP = (bf16*)(ws + WS_WUP); bf16* WDN = (bf16*)(ws + WS_WDN);
    float* cosT = (float*)(ws + WS_COS); float* sinT = (float*)(ws + WS_SIN);
    float* mod = (float*)(ws + WS_CTL + CTL_MOD); float* ssq_q = (float*)(ws + WS_CTL + CTL_SSQQ); float* ssq_kv = (float*)(ws + WS_CTL + CTL_SSQKV);
    bf16* R1 = (bf16*)(ws + WS_R1); bf16* R2 = (bf16*)(ws + WS_R2); bf16* LAT = (bf16*)(ws + WS_LAT); bf16* QB = (bf16*)(ws + WS_Q); bf16* KNB = (bf16*)(ws + WS_KN); bf16* VB = (bf16*)(ws + WS_V); bf16* KRB = (bf16*)(ws + WS_KR);
#ifdef DBG_SG_IN_WS
    bf16* SG = (bf16*)(ws + WS_Q);
#else
    bf16* SG = (bf16*)F.out;
#endif
    bf16* MG = QB; bf16* ACT = QB; float* SIDE = (float*)R2;
    LAS unsigned char* ring = F.lds + RING_OFF;

    if (IN(0)) { p0_prologue(F); } SEAM(0);
    if (IN(1)) for (int rep_ = 0; rep_ < NREP(1); ++rep_) { norm_rows_mod(F, INP(0), R1, INP(5), 1024, 0); } SEAM(1);
    if (IN(2)) { pg8::Gemm g{R1, WIN, DM, DM, DM}; pg8::StaticOrder S; S.init(NT, 4096, F.G, (int)blockIdx.x);
        EpiIn E{R2, LAT, KRB, SG, ssq_q, ssq_kv, cosT, sinT};
        pg8::gemm_phase<EpiIn, pg8::StaticOrder, true, true>(ring, g, S, E, F.wave); } SEAM(2);
    if (IN(3)) for (int rep_ = 0; rep_ < NREP(3); ++rep_) {
        const bool rnn_cu = (F.G == 256) ? ((F.vcu & 31) < 20) : true;
#ifndef NO_RNN
        if (F.G == 256) { if (rnn_cu) { const int u = (F.vcu >> 5) * 20 + (F.vcu & 31); rnn::unit(F, u / 20, u % 20); } }
        else for (int u = F.vcu; u < NB * 20; u += F.G) rnn::unit(F, u / 20, u % 20);
        __syncthreads();
#endif
#ifndef NO_QKV
#ifndef NO_Q
        if (F.G != 256 || !rnn_cu) { pg8::Gemm g{LAT, WUQ, 768, QL, QL}; pg8::StaticOrder S;
          if (F.G == 256) S.init(NT, 1536, 96, ((F.vcu & 31) - 20) * 8 + (F.vcu >> 5)); else S.init(NT, 1536, F.G, (int)blockIdx.x);
          EpiQ E{QB, ssq_q, cosT, sinT};
          pg8::gemm_phase<EpiQ, pg8::StaticOrder, true, true>(ring, g, S, E, F.wave); }
#endif
#ifndef NO_KV
        { pg8::Gemm g{LAT + QL, WUKV, 768, KVL, KVL}; pg8::StaticOrder S; S.init(NT, 2048, F.G, (int)blockIdx.x); EpiKV E{KNB, VB, ssq_kv};
          pg8::gemm_phase<EpiKV, pg8::StaticOrder, true, true>(ring, g, S, E, F.wave); }
#endif
#endif
    } SEAM(3);
    if (IN(4)) for (int rep_ = 0; rep_ < NREP(4); ++rep_) {
        for (int idx = F.vcu; idx < 2048; idx += F.G) { const int v = idx & 255, i = idx >> 8, bh = v >> 1, s = v & 1; const int qb = 2 * i + ((i & 1) ? 1 - s : s);
            att::unit(F, bh >> 4, bh & 15, qb); }
    } SEAM(4);
    if (IN(5)) for (int rep_ = 0; rep_ < NREP(5); ++rep_) {
        { pg8::Gemm g{R1, WPR, DRNN, DRNN, DRNN}; pg8::StaticOrder S; S.init(NT, DM, F.G, (int)blockIdx.x); EpiMerge<false> E{MG, SG, 0};
          pg8::gemm_phase<EpiMerge<false>, pg8::StaticOrder, true, true>(ring, g, S, E, F.wave); }
#ifndef DBG_NO_MERGE_B
        { pg8::Gemm g{R2, WPM, DM, DM, DM}; pg8::StaticOrder S; S.init(NT, DM, F.G, (int)blockIdx.x); EpiMerge<true> E{MG, SG, 1024};
          pg8::gemm_phase<EpiMerge<true>, pg8::StaticOrder, true, true>(ring, g, S, E, F.wave); }
#endif
    } SEAM(5);
    if (IN(6)) for (int rep_ = 0; rep_ < NREP(6); ++rep_) { pg8::Gemm g{MG, WOUT, DM, DM, DM}; pg8::StaticOrder S; S.init(NT, DM, F.G, (int)blockIdx.x); EpiRes E{INP(0), F.out, mod, 2048};
        pg8::gemm_phase<EpiRes, pg8::StaticOrder, true, true>(ring, g, S, E, F.wave); } SEAM(6);
    if (IN(7)) for (int rep_ = 0; rep_ < NREP(7); ++rep_) { norm_rows_mod(F, F.out, R1, INP(21), 4096, 3072); } SEAM(7);
    if (IN(8)) for (int rep_ = 0; rep_ < NREP(8); ++rep_) { pg8::Gemm g{R1, WUP, DM, DM, DM}; pg8::StaticOrder S; S.init(NT, NUP, F.G, (int)blockIdx.x); EpiUp E{ACT, SIDE, INP(23), INP(24)};
        pg8::gemm_phase<EpiUp, pg8::StaticOrder, true, true>(ring, g, S, E, F.wave); } SEAM(8);
    if (IN(9)) for (int rep_ = 0; rep_ < NREP(9); ++rep_) { ffn_fixup(F, ACT, SIDE, INP(23), INP(24)); } SEAM(9);
    if (IN(10)) { pg8::Gemm g{ACT, WDN, DFF, DFF, DFF}; pg8::StaticOrder S; S.init(NT, DM, F.G, (int)blockIdx.x); EpiRes E{F.out, F.out, mod, 5120};
        pg8::gemm_phase<EpiRes, pg8::StaticOrder, true, true>(ring, g, S, E, F.wave); } SEAM(10);
    if (IN(11)) { norm_rows_final(F, F.out, INP(26)); }
#undef IN
#undef SEAM
}

extern "C" void kernel_launch(void* const* d_in, const int* in_sizes, int n_in, void* d_out, int out_size, void* d_ws, size_t ws_size, hipStream_t stream) {
    static int grid = 0;
    if (grid == 0) {
        if (n_in != 27 || in_sizes[0] != NT * DM || out_size != NT * DM || ws_size < WS_END) { fprintf(stderr, "kernel_launch: unexpected shapes (n_in %d, in0 %d, out %d, ws %zu); nothing launched\n", n_in, n_in > 0 ? in_sizes[0] : -1, out_size, ws_size); grid = -1; return; }
        int dev = 0, cus = 0, per_cu = 0;
        if (hipGetDevice(&dev) != hipSuccess || hipDeviceGetAttribute(&cus, hipDeviceAttributeMultiprocessorCount, dev) != hipSuccess) { grid = -1; return; }
        if (hipFuncSetAttribute((const void*)mk_fwd, hipFuncAttributeMaxDynamicSharedMemorySize, LDS_BYTES) != hipSuccess) { fprintf(stderr, "kernel_launch: hipFuncSetAttribute failed\n"); grid = -1; return; }
        if (hipOccupancyMaxActiveBlocksPerMultiprocessor(&per_cu, (const void*)mk_fwd, NWAVES * 64, LDS_BYTES) != hipSuccess || per_cu < 1) { fprintf(stderr, "kernel_launch: occupancy query says %d blocks/CU\n", per_cu); per_cu = 1; }
        (void)hipGetLastError();
        grid = cus;
    }
    if (grid < 0) return;
    (void)hipMemsetAsync((char*)d_ws + WS_CTL, 0, CTL_ZERO_BYTES, stream);
    Args a{};
    for (int i = 0; i < 27; ++i) a.in[i] = (const float*)d_in[i];
    a.out = (float*)d_out; a.ws = (unsigned char*)d_ws;
#ifdef DBG_STOP_AFTER
#ifndef DBG_STAGE
#define DBG_STAGE DBG_STOP_AFTER
#endif
    for (int p = 0; p <= DBG_STOP_AFTER; ++p) { a.ph_lo = p; a.ph_hi = p + 1; hipLaunchKernelGGL(mk_fwd, dim3(grid), dim3(NWAVES * 64), LDS_BYTES, stream, a); }
    hipLaunchKernelGGL(dbg_dump_k, dim3(2048), dim3(256), 0, stream, (float*)d_out, (unsigned char*)d_ws, (int)DBG_STAGE);
#elif MK_N_LAUNCHES == 1
    a.ph_lo = 0; a.ph_hi = N_PHASES;
    hipLaunchKernelGGL(mk_fwd, dim3(grid), dim3(NWAVES * 64), LDS_BYTES, stream, a);
#else
    for (int p = 0; p < N_PHASES; ++p) { a.ph_lo = p; a.ph_hi = p + 1; hipLaunchKernelGGL(mk_fwd, dim3(grid), dim3(NWAVES * 64), LDS_BYTES, stream, a); }
#endif
}
```
